# Optimizing an MI355X kernel written in HIP

```python
import jax
import jax.numpy as jnp
from jax import lax
import numpy as np

D_MODEL = 1024
BATCH = 8
SEQ = 4096
DEPTH = 2
DEC_BATCH = 32
DEC_SEQ = 16
PAST_LEN = 4096

CHUNK = 64
Q_BLOCK = 128
N_HEADS = 8
QK_NOPE = 64
QK_ROPE = 32
QK_HEAD = QK_NOPE + QK_ROPE
V_HEAD = 64
Q_LORA = 384
KV_LORA = 256
ATTN_WIDTH = N_HEADS * V_HEAD
POOL_WINDOWS = (2, 4, 8, 16)
N_POOL_GROUPS = 4
POOL_GROUP = 128
POOL_WIDTH = N_POOL_GROUPS * POOL_GROUP
POOL_HIST = max(POOL_WINDOWS) - 1
D_FF = 4 * D_MODEL
ROPE_THETA = 10000.0
EPS = 1e-6
SM_SCALE = QK_HEAD ** -0.5

OFF_Q = 0
OFF_KV = OFF_Q + Q_LORA
OFF_KR = OFF_KV + KV_LORA
OFF_P = OFF_KR + QK_ROPE
OFF_GA = OFF_P + POOL_WIDTH
OFF_GB = OFF_GA + D_MODEL
IN_WIDTH = OFF_GB + D_MODEL

kernel_name = 'hybrid_mla_pool_stream_step'


def rmsnorm(x, g):
    xf = x.astype(jnp.float32)
    y = xf * lax.rsqrt(jnp.mean(xf * xf, axis=-1, keepdims=True) + EPS)
    return (y * g.astype(jnp.float32)).astype(x.dtype)


def rope(x, pos):
    half = QK_ROPE // 2
    inv = jnp.power(ROPE_THETA, -jnp.arange(half, dtype=jnp.float32) / half)
    ang = pos[:, None] * inv[None, :]
    shape = (1, ang.shape[0]) + (1,) * (x.ndim - 3) + (half,)
    cos = jnp.cos(ang).reshape(shape)
    sin = jnp.sin(ang).reshape(shape)
    xf = x.astype(jnp.float32)
    x1, x2 = xf[..., :half], xf[..., half:]
    return jnp.concatenate([x1 * cos - x2 * sin, x1 * sin + x2 * cos], axis=-1).astype(x.dtype)


def mla_keys_values(c, kr, w_ukv, g_k):
    kv = jnp.einsum('btc,chd->bthd', c, w_ukv)
    k_nope, v = kv[..., :QK_NOPE], kv[..., QK_NOPE:]
    kr_h = jnp.broadcast_to(kr[:, :, None, :], k_nope.shape[:3] + (QK_ROPE,)).astype(k_nope.dtype)
    k = rmsnorm(jnp.concatenate([k_nope, kr_h], axis=-1), g_k)
    return k, v


def mla_queries(cq, w_uq, g_q, pos):
    q = jnp.einsum('btc,chd->bthd', cq, w_uq)
    q = jnp.concatenate([q[..., :QK_NOPE], rope(q[..., QK_NOPE:], pos)], axis=-1)
    return rmsnorm(q, g_q) * SM_SCALE


def attend_prompt(q, k, v):
    B, S = q.shape[0], q.shape[1]
    nb = S // Q_BLOCK
    qb = q.reshape(B, nb, Q_BLOCK, N_HEADS, QK_HEAD).transpose(1, 0, 2, 3, 4)
    k_chunk = jnp.arange(S) // CHUNK

    def block(args):
        i, qi = args
        q_chunk = (i * Q_BLOCK + jnp.arange(Q_BLOCK)) // CHUNK
        mask = k_chunk[None, :] <= q_chunk[:, None]
        s = jnp.einsum('bqhd,bkhd->bhqk', qi, k).astype(jnp.float32)
        s = jnp.where(mask[None, None], s, -jnp.inf)
        p = jax.nn.softmax(s, axis=-1).astype(v.dtype)
        return jnp.einsum('bhqk,bkhd->bqhd', p, v)

    out = lax.map(block, (jnp.arange(nb), qb))
    return out.transpose(1, 0, 2, 3, 4).reshape(B, S, ATTN_WIDTH)


def attend_all(q, k, v):
    B, T = q.shape[0], q.shape[1]
    s = jnp.einsum('bqhd,bkhd->bhqk', q, k).astype(jnp.float32)
    p = jax.nn.softmax(s, axis=-1).astype(v.dtype)
    return jnp.einsum('bhqk,bkhd->bqhd', p, v).reshape(B, T, ATTN_WIDTH)


def pool_mix(p_ext, n_hist, pos0):
    B, L, W = p_ext.shape
    T = L - n_hist
    pf = p_ext.astype(jnp.float32)
    cs = jnp.concatenate([jnp.zeros((B, 1, W), jnp.float32), jnp.cumsum(pf, axis=1)], axis=1)
    t = jnp.arange(n_hist, L)
    pos = pos0 + jnp.arange(T)
    hi = cs[:, t + 1]
    outs = []
    for g, w in enumerate(POOL_WINDOWS):
        sl = slice(g * POOL_GROUP, (g + 1) * POOL_GROUP)
        lo_idx = jnp.maximum(t + 1 - w, 0)
        cnt = jnp.minimum(w, pos + 1).astype(jnp.float32)
        mean = (hi[..., sl] - cs[:, lo_idx, sl]) / cnt[None, :, None]
        outs.append(mean - pf[:, n_hist:, sl])
    return jnp.concatenate(outs, axis=-1).astype(p_ext.dtype)


def trunk_layer(x, pos0, hist_c, hist_kr, hist_p, g_mix, w_in, g_qa, g_kva, w_uq, w_ukv,
                g_q, g_k, w_attn_out, w_pool, pool_scale, w_pool_out, w_o, g_mlp, w_up, w_down):
    B, T, _ = x.shape
    pos = pos0 + jnp.arange(T, dtype=jnp.float32)
    h = rmsnorm(x, g_mix)
    z = jnp.einsum('btd,de->bte', h, w_in)
    cq = rmsnorm(z[..., OFF_Q:OFF_KV], g_qa)
    ckv = rmsnorm(z[..., OFF_KV:OFF_KR], g_kva)
    kr = rope(z[..., OFF_KR:OFF_P], pos)
    p = z[..., OFF_P:OFF_GA]
    gate_a = jax.nn.sigmoid(z[..., OFF_GA:OFF_GB])
    gate_b = jax.nn.sigmoid(z[..., OFF_GB:IN_WIDTH])
    q = mla_queries(cq, w_uq, g_q, pos)
    if hist_c is None:
        k, v = mla_keys_values(ckv, kr, w_ukv, g_k)
        attn = attend_prompt(q, k, v)
        p_ext, n_hist = p, 0
    else:
        c_all = jnp.concatenate([hist_c.astype(ckv.dtype), ckv], axis=1)
        kr_all = jnp.concatenate([hist_kr.astype(kr.dtype), kr], axis=1)
        k, v = mla_keys_values(c_all, kr_all, w_ukv, g_k)
        attn = attend_all(q, k, v)
        p_ext, n_hist = jnp.concatenate([hist_p.astype(p.dtype), p], axis=1), POOL_HIST
    pooled = pool_mix(p_ext, n_hist, pos0)
    u = jnp.einsum('btgc,gce->btge', pooled.reshape(B, T, N_POOL_GROUPS, POOL_GROUP), w_pool)
    u = u.reshape(B, T, POOL_WIDTH) * pool_scale
    branch_a = jnp.einsum('btc,cd->btd', attn, w_attn_out)
    branch_b = jnp.einsum('btc,cd->btd', u, w_pool_out)
    x = x + jnp.einsum('btd,de->bte', gate_a * branch_a + gate_b * branch_b, w_o)
    hm = rmsnorm(x, g_mlp)
    a = jnp.square(jax.nn.relu(jnp.einsum('btd,df->btf', hm, w_up)))
    x = x + jnp.einsum('btf,fd->btd', a, w_down)
    return x, ckv, kr, p_ext[:, -POOL_HIST:]


def setup_inputs(seed: int = 0) -> dict:
    key = jax.random.key(seed)
    ks = jax.random.split(key, 24)

    def nrm(k, shape, scale):
        return jax.random.normal(k, shape, jnp.float32) * scale

    def gain(k, shape):
        return 1.0 + 0.05 * jax.random.normal(k, shape, jnp.float32)

    return {
        'x_prompt': nrm(ks[0], (BATCH, SEQ, D_MODEL), 1.0),
        'x_sample': nrm(ks[1], (DEC_BATCH, DEC_SEQ, D_MODEL), 1.0),
        'cache_ckv': nrm(ks[2], (DEPTH, DEC_BATCH, PAST_LEN, KV_LORA), 1.0),
        'cache_krope': nrm(ks[3], (DEPTH, DEC_BATCH, PAST_LEN, QK_ROPE), 1.0),
        'state_pool': nrm(ks[4], (DEPTH, DEC_BATCH, POOL_HIST, POOL_WIDTH), 1.0),
        'g_mix': gain(ks[5], (DEPTH, D_MODEL)),
        'w_in': nrm(ks[6], (DEPTH, D_MODEL, IN_WIDTH), D_MODEL ** -0.5),
        'g_qa': gain(ks[7], (DEPTH, Q_LORA)),
        'g_kva': gain(ks[8], (DEPTH, KV_LORA)),
        'w_uq': nrm(ks[9], (DEPTH, Q_LORA, N_HEADS, QK_HEAD), Q_LORA ** -0.5),
        'w_ukv': nrm(ks[10], (DEPTH, KV_LORA, N_HEADS, QK_NOPE + V_HEAD), KV_LORA ** -0.5),
        'g_q': gain(ks[11], (DEPTH, QK_HEAD)),
        'g_k': gain(ks[12], (DEPTH, QK_HEAD)),
        'w_attn_out': nrm(ks[13], (DEPTH, ATTN_WIDTH, D_MODEL), ATTN_WIDTH ** -0.5),
        'w_pool': nrm(ks[14], (DEPTH, N_POOL_GROUPS, POOL_GROUP, POOL_GROUP), POOL_GROUP ** -0.5),
        'pool_scale': gain(ks[15], (DEPTH, POOL_WIDTH)),
        'w_pool_out': nrm(ks[16], (DEPTH, POOL_WIDTH, D_MODEL), POOL_WIDTH ** -0.5),
        'w_o': nrm(ks[17], (DEPTH, D_MODEL, D_MODEL), D_MODEL ** -0.5),
        'g_mlp': gain(ks[18], (DEPTH, D_MODEL)),
        'w_up': nrm(ks[19], (DEPTH, D_MODEL, D_FF), D_MODEL ** -0.5),
        'w_down': nrm(ks[20], (DEPTH, D_FF, D_MODEL), D_FF ** -0.5),
    }


def reference(x_prompt, x_sample, cache_ckv, cache_krope, state_pool, g_mix, w_in, g_qa, g_kva,
              w_uq, w_ukv, g_q, g_k, w_attn_out, w_pool, pool_scale, w_pool_out, w_o, g_mlp,
              w_up, w_down):
    past = cache_ckv.shape[2]
    yp, ys = x_prompt, x_sample
    ckv_p, kr_p, pool_p, ckv_s, kr_s, pool_s = [], [], [], [], [], []
    for l in range(DEPTH):
        w = (g_mix[l], w_in[l], g_qa[l], g_kva[l], w_uq[l], w_ukv[l], g_q[l], g_k[l],
             w_attn_out[l], w_pool[l], pool_scale[l], w_pool_out[l], w_o[l], g_mlp[l],
             w_up[l], w_down[l])
        yp, c1, r1, s1 = trunk_layer(yp, 0, None, None, None, *w)
        ys, c2, r2, s2 = trunk_layer(ys, past, cache_ckv[l], cache_krope[l], state_pool[l], *w)
        ckv_p.append(c1)
        kr_p.append(r1)
        pool_p.append(s1)
        ckv_s.append(c2)
        kr_s.append(r2)
        pool_s.append(s2)
    return (yp, ys, jnp.stack(ckv_p), jnp.stack(kr_p), jnp.stack(pool_p),
            jnp.stack(ckv_s), jnp.stack(kr_s), jnp.stack(pool_s))
```

```cpp
#include <hip/hip_runtime.h>
#include <hip/hip_cooperative_groups.h>
#include <cstdio>
#include <cstdint>
namespace cg = cooperative_groups;

#define DEVI __device__ __forceinline__
#define LAS __attribute__((address_space(3)))
__device__ __forceinline__ int opq_v(int x) { asm volatile("" : "+v"(x)); return x; }
__device__ __forceinline__ int opq_s(int x) { asm volatile("" : "+s"(x)); return x; }
__device__ __forceinline__ int tid_now(int wv) { int r; asm volatile("v_mbcnt_lo_u32_b32 %0, -1, 0\n\tv_mbcnt_hi_u32_b32 %0, -1, %0\n\tv_lshl_or_b32 %0, %1, 6, %0" : "=&v"(r) : "s"(wv)); return r; }
#define TID() tid_now(wv)
#define BID() opq_s((int)blockIdx.x)
#define GDIM() opq_s((int)gridDim.x)
typedef unsigned short bf16_t;
typedef short bf16x8 __attribute__((ext_vector_type(8)));
typedef float f32x4 __attribute__((ext_vector_type(4)));
typedef float f32x16 __attribute__((ext_vector_type(16)));
typedef unsigned u32x4 __attribute__((ext_vector_type(4)));
typedef unsigned u32x2 __attribute__((ext_vector_type(2)));
typedef float f32x2_t __attribute__((ext_vector_type(2)));
typedef __bf16 bf16x2_t __attribute__((ext_vector_type(2)));

constexpr int DM = 1024, MP = 32768, MS = 512, MT = MP + MS, MC = 131072, DFF = 4096;
constexpr int NZ = 3328;
constexpr int KSL = 4160;
constexpr float EPSF = 1e-6f;
constexpr float QSCALE = 0.10206207261596575f * 1.4426950408889634f;

DEVI unsigned cvtpk(float lo, float hi) { f32x2_t v = {lo, hi}; bf16x2_t b = __builtin_convertvector(v, bf16x2_t); return __builtin_bit_cast(unsigned, b); }
DEVI u32x4 pack8(const f32x4 a, const f32x4 b) { u32x4 w; w.x = cvtpk(a[0], a[1]); w.y = cvtpk(a[2], a[3]); w.z = cvtpk(b[0], b[1]); w.w = cvtpk(b[2], b[3]); return w; }
DEVI float bflo(unsigned w) { return __uint_as_float(w << 16); }
DEVI float bfhi(unsigned w) { return __uint_as_float(w & 0xffff0000u); }
DEVI f32x4 unpk_lo(const u32x4 w) { return (f32x4){bflo(w.x), bfhi(w.x), bflo(w.y), bfhi(w.y)}; }
DEVI f32x4 unpk_hi(const u32x4 w) { return (f32x4){bflo(w.z), bfhi(w.z), bflo(w.w), bfhi(w.w)}; }
DEVI float ss4(const f32x4 a) { return (a[0] * a[0] + a[1] * a[1]) + (a[2] * a[2] + a[3] * a[3]); }
DEVI float red_fq(float s) { s += __shfl_xor(s, 16); s += __shfl_xor(s, 32); return s; }
DEVI float max3a(float a, float b, float c) { float r; asm("v_max3_f32 %0, %1, %2, %3" : "=v"(r) : "v"(a), "v"(b), "v"(c)); return r; }
DEVI float max2a(float a, float b) { float r; asm("v_max_f32_e32 %0, %1, %2" : "=v"(r) : "v"(a), "v"(b)); return r; }
DEVI float sigm(float x) { return __builtin_amdgcn_rcpf(1.f + __builtin_amdgcn_exp2f(-1.4426950408889634f * x)); }

namespace pg8 {
constexpr int BM = 256, BK = 64, HALF = 128, HTB = HALF * BK * 2, STAGE_BYTES = 8 * HTB, NXCD = 8, WGM = 8;
__host__ __device__ __forceinline__ int lds_byte(int r, int c) { const int st = (r >> 4) * 2 + (c >> 5), rr = r & 15, cc = c & 31, ob = rr * 64 + cc * 2; return st * 1024 + (ob ^ (((ob >> 9) & 1) << 5)); }
__host__ __device__ __forceinline__ void stage_rc(int b, int& R, int& C) { const int st = b / 1024, sb = b % 1024, swz = sb ^ (((sb >> 9) & 1) << 5); R = (st >> 1) * 16 + swz / 64; C = (st & 1) * 32 + (swz % 64) / 2; }
__host__ __device__ __forceinline__ int perm32(int rho) { const int n = rho >> 4, i = rho & 15; return 8 * (i >> 2) + 4 * n + (i & 3); }

struct Unit { int pm, pn, ks; };
struct Gemm { const bf16_t* A; const bf16_t* Bt; int lda, ldb, K, nNr; };

struct StaticOrder {
    int nM, nN, nwg, G, c;
    __device__ void init(int M, int N, int G_, int c_) { nM = M / BM; nN = N / BM; nwg = nM * nN; G = G_; c = c_; }
    __device__ bool next(int i, Unit& u) const {
        const long L = (long)i * G + c; if (L >= nwg) return false;
        int wgid = (int)L; { const int q = nwg / NXCD, r = nwg % NXCD, xcd = wgid % NXCD, off = wgid / NXCD; wgid = (xcd < r ? xcd * (q + 1) : r * (q + 1) + (xcd - r) * q) + off; }
        const int nig = WGM * nN, gid = wgid / nig, fm = gid * WGM, gsz = (nM - fm) < WGM ? (nM - fm) : WGM;
        u.pm = fm + ((wgid % nig) % gsz); u.pn = (wgid % nig) / gsz; return true;
    }
};

template <class Epi, class Sched>
__device__ __forceinline__ void gemm_phase(int wv, LAS unsigned char* lds, const Gemm g, const Sched& S, const Epi& E) {
    const int tid = TID(), wid = __builtin_amdgcn_readfirstlane(tid >> 6), lane = tid & 63, wr = wid >> 2, wc = wid & 3, fr = lane & 15, fq = lane >> 4;
    const int K = g.K, nt = K / BK;
    unsigned voffA[2], voffB[2];
#pragma unroll
    for (int i = 0; i < 2; ++i) { int R, C; stage_rc(tid * 16 + i * 8192, R, C); const int Rb = Epi::PERM ? ((R & ~31) + perm32(R & 31)) : R;
        voffA[i] = (unsigned)(R * g.lda + C) * 2u; voffB[i] = (unsigned)(Rb * g.ldb + C) * 2u; }
    const size_t kstep = (size_t)(BK * 2);
    const unsigned hA = (unsigned)HALF * g.lda * 2u, hB = (unsigned)HALF * g.ldb * 2u;
    const unsigned tA = 2u * hA, tB = 2u * hB;
    const unsigned ldsw = (unsigned)wid * 1024u;
    const int aoff = lds_byte(wr * 64 + fr, fq * 8), boff = lds_byte(wc * 32 + fr, fq * 8);
#define PG8_SA(b, h) (((b) * 2 + (h)) * HTB)
#define PG8_SB(b, h) ((4 + (b) * 2 + (h)) * HTB)
#define PG8_STAGE(bufoff, gbase, voff) do { _Pragma("unroll") for (int _i = 0; _i < 2; ++_i) \
        __builtin_amdgcn_global_load_lds((const unsigned*)((const char*)(gbase) + (voff)[_i]), (LAS unsigned*)(lds + (bufoff) + ldsw + _i * 8192), 16, 0, 0); } while (0)
#define PG8_LDA(dst, b, h) do { _Pragma("unroll") for (int m = 0; m < 4; ++m) _Pragma("unroll") for (int k = 0; k < 2; ++k) dst[m][k] = *(const LAS bf16x8*)(lds + PG8_SA(b, h) + aoff + m * 2048 + k * 1024); } while (0)
#define PG8_LDB(dst, b, h) do { _Pragma("unroll") for (int n = 0; n < 2; ++n) _Pragma("unroll") for (int k = 0; k < 2; ++k) dst[n][k] = *(const LAS bf16x8*)(lds + PG8_SB(b, h) + boff + n * 2048 + k * 1024); } while (0)
#define PG8_MMA(ai, bj, At, Bt) do { __builtin_amdgcn_s_setprio(1); _Pragma("unroll") for (int m = 0; m < 4; ++m) _Pragma("unroll") for (int n = 0; n < 2; ++n) _Pragma("unroll") for (int k = 0; k < 2; ++k) \
        acc[ai][bj][m][n] = __builtin_amdgcn_mfma_f32_16x16x32_bf16(Bt[n][k], At[m][k], acc[ai][bj][m][n], 0, 0, 0); __builtin_amdgcn_s_setprio(0); } while (0)
#define PG8_WAIT_V(n) asm volatile("s_waitcnt vmcnt(" #n ")" ::: "memory")
#define PG8_WAIT_L(n) asm volatile("s_waitcnt lgkmcnt(" #n ")" ::: "memory")
#define PG8_BAR __builtin_amdgcn_s_barrier()
#define PG8_SCHED __builtin_amdgcn_sched_barrier(0)
    Unit cur, nxt; int ui = 0;
    if (!S.next(0, cur)) return;
    f32x4 acc[2][2][4][2];
#pragma unroll
    for (int a = 0; a < 2; ++a)
#pragma unroll
        for (int b = 0; b < 2; ++b)
#pragma unroll
            for (int m = 0; m < 4; ++m)
#pragma unroll
                for (int n = 0; n < 2; ++n) acc[a][b][m][n] = (f32x4){0.f, 0.f, 0.f, 0.f};
    bf16x8 At[4][2], B0[2][2], B1[2][2];
#define PG8_UA(u) ((const char*)g.A + (size_t)(u).pm * tA + (g.nNr ? (size_t)((u).pn / g.nNr) * K * 2 : (size_t)0))
#define PG8_UB(u) ((const char*)g.Bt + (size_t)(g.nNr ? (u).pn % g.nNr : (u).pn) * tB + (g.nNr ? (size_t)((u).pn / g.nNr) * K * 2 : (size_t)0))
    const char* cA = PG8_UA(cur); const char* cB = PG8_UB(cur);
    PG8_STAGE(PG8_SB(0, 0), cB, voffB); PG8_STAGE(PG8_SB(0, 1), cB + hB, voffB); PG8_STAGE(PG8_SA(0, 0), cA, voffA); PG8_STAGE(PG8_SA(0, 1), cA + hA, voffA);
    if (wr == 1) PG8_BAR;
    PG8_WAIT_V(2); PG8_BAR;
    PG8_STAGE(PG8_SB(1, 0), cB + kstep, voffB); PG8_STAGE(PG8_SA(1, 0), cA + kstep, voffA); PG8_STAGE(PG8_SB(1, 1), cB + hB + kstep, voffB);
    PG8_WAIT_V(6); PG8_BAR;
    for (;;) {
        const bool has_next = S.next(ui + 1, nxt);
        const char* nA = has_next ? PG8_UA(nxt) : cA; const char* nB = has_next ? PG8_UB(nxt) : cB;
        for (int t = 0; t < nt; t += 2) {
            const bool last = (t == nt - 2);
            const char* a1 = cA + (size_t)(t + 1) * kstep;
            const char* a2 = last ? nA : cA + (size_t)(t + 2) * kstep; const char* b2 = last ? nB : cB + (size_t)(t + 2) * kstep;
            const char* a3 = a2 + kstep; const char* b3 = b2 + kstep;
            PG8_LDB(B0, 0, 0); PG8_LDB(B1, 0, 1); PG8_SCHED; PG8_LDA(At, 0, 0); PG8_STAGE(PG8_SA(1, 1), a1 + hA, voffA);
            PG8_WAIT_V(8); PG8_WAIT_L(0); PG8_BAR; PG8_MMA(0, 0, At, B0); PG8_MMA(0, 1, At, B1); PG8_BAR; PG8_SCHED;
            PG8_LDA(At, 0, 1); PG8_STAGE(PG8_SB(0, 0), b2, voffB); PG8_STAGE(PG8_SB(0, 1), b2 + hB, voffB); PG8_STAGE(PG8_SA(0, 0), a2, voffA);
            PG8_WAIT_V(8); PG8_WAIT_L(0); PG8_BAR; PG8_MMA(1, 0, At, B0); PG8_MMA(1, 1, At, B1); PG8_BAR; PG8_SCHED;
            PG8_LDB(B0, 1, 0); PG8_LDB(B1, 1, 1); PG8_SCHED; PG8_LDA(At, 1, 0); PG8_STAGE(PG8_SA(0, 1), a2 + hA, voffA);
            PG8_WAIT_V(8); PG8_WAIT_L(0); PG8_BAR; PG8_MMA(0, 0, At, B0); PG8_MMA(0, 1, At, B1); PG8_BAR; PG8_SCHED;
            PG8_LDA(At, 1, 1); PG8_STAGE(PG8_SB(1, 0), b3, voffB); PG8_STAGE(PG8_SB(1, 1), b3 + hB, voffB); PG8_STAGE(PG8_SA(1, 0), a3, voffA);
            PG8_WAIT_V(8); PG8_WAIT_L(0); PG8_BAR; PG8_MMA(1, 0, At, B0); PG8_MMA(1, 1, At, B1); PG8_BAR; PG8_SCHED;
        }
        if (wr == 0) PG8_BAR;
        { const int t2 = TID(), w2 = __builtin_amdgcn_readfirstlane(t2 >> 6), l2 = t2 & 63; Unit eu = cur; eu.ks = 0; if (g.nNr) { eu.pn = cur.pn % g.nNr; eu.ks = cur.pn / g.nNr; } E(acc, eu, w2 >> 2, w2 & 3, l2 & 15, l2 >> 4); }
        if (!has_next) break;
#pragma unroll
        for (int a = 0; a < 2; ++a)
#pragma unroll
            for (int b = 0; b < 2; ++b)
#pragma unroll
                for (int m = 0; m < 4; ++m)
#pragma unroll
                    for (int n = 0; n < 2; ++n) acc[a][b][m][n] = (f32x4){0.f, 0.f, 0.f, 0.f};
        cur = nxt; cA = nA; cB = nB; ++ui;
        if (wr == 1) PG8_BAR;
    }
    PG8_WAIT_V(0);
    PG8_BAR;
#undef PG8_UA
#undef PG8_UB
#undef PG8_SA
#undef PG8_SB
#undef PG8_STAGE
#undef PG8_LDA
#undef PG8_LDB
#undef PG8_MMA
#undef PG8_WAIT_V
#undef PG8_WAIT_L
#undef PG8_BAR
#undef PG8_SCHED
}
}
using pg8::Unit;


constexpr size_t A256(size_t x) { return (x + 255) & ~(size_t)255; }
constexpr size_t O_CTL = 0;
constexpr size_t O_ROPE = 16384;
constexpr size_t O_SSQA0 = O_ROPE + A256((size_t)4112 * 16 * 8);
constexpr size_t O_SSQZ = O_SSQA0 + A256((size_t)MT * 4);
constexpr size_t SSQZ_FLOATS = (size_t)MT * (1 + 2 + 2 + 2 + 16);
constexpr size_t O_W = O_SSQZ + A256(SSQZ_FLOATS * 4);
constexpr size_t W_IN = 0, W_UQ = W_IN + (size_t)NZ * 1024 * 2, W_K = W_UQ + (size_t)768 * 384 * 2, W_V = W_K + 512 * 256 * 2, W_KC = W_V + 512 * 256 * 2, W_VC = W_KC + 512 * 256 * 2,
                 W_A = W_VC + 512 * 256 * 2, W_EFF = W_A + 1024 * 512 * 2, W_O = W_EFF + 1024 * 512 * 2, W_UP = W_O + 1024 * 1024 * 2, W_DN = W_UP + (size_t)4096 * 1024 * 2, W_LAYER = W_DN + (size_t)4096 * 1024 * 2;
constexpr size_t O_CKVB = O_W + 2 * W_LAYER;
constexpr size_t O_XB = O_CKVB + (size_t)2 * MC * 256 * 2;
constexpr size_t O_ZQ = O_XB + (size_t)MT * 1024 * 2;
constexpr size_t O_ZKV = O_ZQ + (size_t)MT * 384 * 2;
constexpr size_t O_PP = O_ZKV + (size_t)MT * 256 * 2;
constexpr size_t O_GA = O_PP + (size_t)MT * 512 * 2;
constexpr size_t O_GB = O_GA + (size_t)MT * 1024 * 2;
constexpr size_t O_POOLED = O_GB + (size_t)MT * 1024 * 2;
constexpr size_t O_QP = O_POOLED + (size_t)MT * 512 * 2;
constexpr size_t O_QS = O_QP + (size_t)MP * 768 * 2;
constexpr size_t O_KP = O_QS + (size_t)MS * 768 * 2;
constexpr size_t O_VTP = O_KP + (size_t)MP * 768 * 2;
constexpr size_t O_ATT = O_VTP + (size_t)MP * 512 * 2;
constexpr size_t O_KS = O_ATT + (size_t)MT * 512 * 2;
constexpr size_t O_VTS = O_KS + (size_t)256 * KSL * 96 * 2;
constexpr size_t O_END = O_VTS + (size_t)256 * 64 * KSL * 2;
constexpr size_t O_CKVN = O_END;
constexpr size_t O_END2 = O_CKVN + (size_t)MS * 256 * 2;
constexpr size_t O_AH = O_KS;
static_assert((size_t)MT * DFF * 2 <= O_END - O_KS, "FFN hidden overlay");

constexpr size_t OUT_Y = 0, OUT_CKVP = (size_t)MT * 1024, OUT_KRP = OUT_CKVP + (size_t)2 * MP * 256, OUT_PLP = OUT_KRP + (size_t)2 * MP * 32, OUT_CKVS = OUT_PLP + (size_t)2 * 8 * 15 * 512,
                 OUT_KRS = OUT_CKVS + (size_t)2 * MS * 256, OUT_PLS = OUT_KRS + (size_t)2 * MS * 32;

constexpr int LDS_BYTES = 147456;

typedef const __attribute__((address_space(4))) unsigned char* karg_t;
DEVI karg_t kargs() { karg_t p = (karg_t)__builtin_amdgcn_kernarg_segment_ptr(); asm volatile("" : "+s"(p)); return p; }
DEVI const float* IN(int i) { return *(const float* const __attribute__((address_space(4)))*)(kargs() + 8 * i); }
DEVI float* OUTP() { return *(float* const __attribute__((address_space(4)))*)(kargs() + 8 * 21); }
DEVI unsigned char* WSP() { return *(unsigned char* const __attribute__((address_space(4)))*)(kargs() + 8 * 22); }
#define FENCE() asm volatile("" ::: "memory")

DEVI void rope_cs(int pos, int half, int j, float& c, float& s) {
    constexpr float KREV[8] = {0.15915494309189535f, 0.08949940160889101f, 0.050329212104487035f, 0.0283021958306234f, 0.015915494309189534f, 0.008949940160889102f, 0.005032921210448704f, 0.00283021958306234f};
    const float rev = __builtin_amdgcn_fractf((float)pos * (KREV[j] * (half ? 0.01f : 1.f)));
    c = __builtin_amdgcn_cosf(rev); s = __builtin_amdgcn_sinf(rev);
}

typedef const f32x4 (&AccRef)[2][2][4][2];
#define ROWLOOP _Pragma("unroll") for (int ai = 0; ai < 2; ++ai) _Pragma("unroll") for (int m = 0; m < 4; ++m)
#define ROWOF(u) ((u).pm * 256 + ai * 128 + wr * 64 + m * 16 + fr)

struct EpiZ {
    static constexpr bool PERM = true;
    int l;
    DEVI void operator()(AccRef acc, const Unit& u, int wr, int wc, int fr, int fq) const {
        unsigned char* ws = WSP(); float* out = OUTP();
        const float* ssqx = (const float*)(ws + (l == 0 ? O_SSQA0 : O_SSQZ));
        float* ssqz = (float*)(ws + O_SSQZ);
        const int pn = u.pn, cw = wc * 32 + 8 * fq;
        float rq[2][4];
        ROWLOOP rq[ai][m] = ssqx[ROWOF(u)];
        ROWLOOP {
            const int row = ROWOF(u);
            const float r = rsqrtf(rq[ai][m] * (1.f / 1024.f) + EPSF);
            const f32x4 v00 = acc[ai][0][m][0] * r, v01 = acc[ai][0][m][1] * r, v10 = acc[ai][1][m][0] * r, v11 = acc[ai][1][m][1] * r;
            if (pn == 0) {
                bf16_t* zq = (bf16_t*)(ws + O_ZQ) + (size_t)row * 384 + cw;
                *(u32x4*)zq = pack8(v00, v01); *(u32x4*)(zq + 128) = pack8(v10, v11);
                const float s = red_fq((ss4(v00) + ss4(v01)) + (ss4(v10) + ss4(v11)));
                if (fq == 0) unsafeAtomicAdd(ssqz + (size_t)(3 + l) * MT + row, s);
            } else if (pn == 1) {
                bf16_t* zq = (bf16_t*)(ws + O_ZQ) + (size_t)row * 384 + 256 + cw;
                *(u32x4*)zq = pack8(v00, v01);
                const float s = red_fq(ss4(v00) + ss4(v01));
                if (fq == 0) unsafeAtomicAdd(ssqz + (size_t)(3 + l) * MT + row, s);
                if (wc == 0) {
                    const int pos = row < MP ? (row & 4095) : 4096 + ((row - MP) & 15);
                    float* dst = row < MP ? out + OUT_KRP + ((size_t)l * MP + row) * 32 : out + OUT_KRS + ((size_t)l * MS + (row - MP)) * 32;
                    const float sg = fq < 2 ? -1.f : 1.f;
                    f32x4 o0, o1;
#pragma unroll
                    for (int j = 0; j < 4; ++j) { float cc, sn; rope_cs(pos, fq & 1, j, cc, sn); const float ot = __shfl_xor(v10[j], 32); o0[j] = v10[j] * cc + sg * ot * sn; }
#pragma unroll
                    for (int j = 0; j < 4; ++j) { float cc, sn; rope_cs(pos, fq & 1, 4 + j, cc, sn); const float ot = __shfl_xor(v11[j], 32); o1[j] = v11[j] * cc + sg * ot * sn; }
                    *(f32x4*)(dst + 8 * fq) = o0; *(f32x4*)(dst + 8 * fq + 4) = o1;
                }
            } else if (pn == 2) {
                bf16_t* zkv = (bf16_t*)(ws + O_ZKV) + (size_t)row * 256 + cw;
                *(u32x4*)zkv = pack8(v00, v01); *(u32x4*)(zkv + 128) = pack8(v10, v11);
                const float s = red_fq((ss4(v00) + ss4(v01)) + (ss4(v10) + ss4(v11)));
                if (fq == 0) unsafeAtomicAdd(ssqz + (size_t)(5 + l) * MT + row, s);
            } else if (pn <= 4) {
                const int col = (pn - 3) * 256 + cw;
                bf16_t* pp = (bf16_t*)(ws + O_PP) + (size_t)row * 512 + col;
                *(u32x4*)pp = pack8(v00, v01); *(u32x4*)(pp + 128) = pack8(v10, v11);
                float* pd = nullptr;
                if (row < MP) { const int t = row & 4095; if (t >= 4081) pd = out + OUT_PLP + ((size_t)l * 8 * 15 + (row >> 12) * 15 + (t - 4081)) * 512; }
                else { const int rr = row - MP, i = rr & 15; if (i >= 1) pd = out + OUT_PLS + ((size_t)l * 32 * 15 + (rr >> 4) * 15 + (i - 1)) * 512; }
                if (pd) { *(f32x4*)(pd + col) = v00; *(f32x4*)(pd + col + 4) = v01; *(f32x4*)(pd + col + 128) = v10; *(f32x4*)(pd + col + 132) = v11; }
            } else {
                bf16_t* g = (bf16_t*)(ws + (pn <= 8 ? O_GA : O_GB)) + (size_t)row * 1024 + ((pn - 5) & 3) * 256 + cw;
                f32x4 a, b, c, d;
#pragma unroll
                for (int j = 0; j < 4; ++j) { a[j] = sigm(v00[j]); b[j] = sigm(v01[j]); c[j] = sigm(v10[j]); d[j] = sigm(v11[j]); }
                *(u32x4*)g = pack8(a, b); *(u32x4*)(g + 128) = pack8(c, d);
            }
            FENCE();
        }
    }
};

DEVI bf16_t* q_ptr(unsigned char* ws, int row, int hd) {
    if (row < MP) return (bf16_t*)(ws + O_QP) + ((size_t)((row >> 12) * 8 + hd) * 4096 + (row & 4095)) * 96;
    const int rr = row - MP; return (bf16_t*)(ws + O_QS) + ((size_t)((rr >> 4) * 8 + hd) * 16 + (rr & 15)) * 96;
}
struct EpiQ {
    static constexpr bool PERM = true;
    int l;
    DEVI void operator()(AccRef acc, const Unit& u, int wr, int wc, int fr, int fq) const {
        unsigned char* ws = WSP(); const float* gq = IN(11) + l * 96;
        const float* ssq_zq = (const float*)(ws + O_SSQZ) + (size_t)(3 + l) * MT;
        float* ssq_qh = (float*)(ws + O_SSQZ) + (size_t)(7 + 8 * l) * MT;
        const int pn = u.pn;
        const f32x4 gA = *(const f32x4*)(gq + (pn < 2 ? 0 : 64) + 8 * fq), gB = *(const f32x4*)(gq + (pn < 2 ? 4 : 68) + 8 * fq), gC = *(const f32x4*)(gq + 32 + 8 * fq), gD = *(const f32x4*)(gq + 36 + 8 * fq);
        float rq[2][4];
        ROWLOOP rq[ai][m] = ssq_zq[ROWOF(u)];
        ROWLOOP {
            const int row = ROWOF(u);
            const float r = rsqrtf(rq[ai][m] * (1.f / 384.f) + EPSF);
            const f32x4 v00 = acc[ai][0][m][0] * r, v01 = acc[ai][0][m][1] * r, v10 = acc[ai][1][m][0] * r, v11 = acc[ai][1][m][1] * r;
            if (pn < 2) {
                const int hd = 4 * pn + wc;
                const float s = red_fq((ss4(v00) + ss4(v01)) + (ss4(v10) + ss4(v11)));
                if (fq == 0) unsafeAtomicAdd(ssq_qh + (size_t)row * 8 + hd, s);
                bf16_t* qd = q_ptr(ws, row, hd);
                *(u32x4*)(qd + 8 * fq) = pack8(v00 * gA, v01 * gB); *(u32x4*)(qd + 32 + 8 * fq) = pack8(v10 * gC, v11 * gD);
            } else {
                const int pos = row < MP ? (row & 4095) : 4096 + ((row - MP) & 15);
                const float sg = fq < 2 ? -1.f : 1.f;
                float cs[8], sn[8];
#pragma unroll
                for (int j = 0; j < 8; ++j) rope_cs(pos, fq & 1, j, cs[j], sn[j]);
                const f32x4 g0 = gA, g1 = gB;
#pragma unroll
                for (int bj = 0; bj < 2; ++bj) {
                    const f32x4 x0 = bj ? v10 : v00, x1 = bj ? v11 : v01;
                    const int hd = 4 * bj + wc;
                    const float s = red_fq(ss4(x0) + ss4(x1));
                    if (fq == 0) unsafeAtomicAdd(ssq_qh + (size_t)row * 8 + hd, s);
                    f32x4 o0, o1;
#pragma unroll
                    for (int j = 0; j < 4; ++j) { const float ot = __shfl_xor(x0[j], 32); o0[j] = x0[j] * cs[j] + sg * ot * sn[j]; }
#pragma unroll
                    for (int j = 0; j < 4; ++j) { const float ot = __shfl_xor(x1[j], 32); o1[j] = x1[j] * cs[4 + j] + sg * ot * sn[4 + j]; }
                    *(u32x4*)(q_ptr(ws, row, hd) + 64 + 8 * fq) = pack8(o0 * g0, o1 * g1);
                }
            }
            FENCE();
        }
    }
};

struct EpiK {
    static constexpr bool PERM = true;
    int l, cache;
    DEVI void operator()(AccRef acc, const Unit& u, int wr, int wc, int fr, int fq) const {
        unsigned char* ws = WSP(); const float* gk = IN(12) + l * 96;
        const float* krc = cache ? IN(3) + (size_t)l * MC * 32 : OUTP();
        const float* ssq_zkv = (const float*)(ws + O_SSQZ) + (size_t)(5 + l) * MT;
        const int hd = 4 * u.pn + wc;
        const bool samp = !cache && (u.pm * 256 >= MP);
        bf16_t* kbase = (bf16_t*)(ws + ((cache || samp) ? O_KS : O_KP));
#pragma unroll
        for (int ai = 0; ai < 2; ++ai) {
            f32x4 k0[4], k1[4]; float rr[4]; unsigned ko[4];
#pragma unroll
            for (int m = 0; m < 4; ++m) {
                const int row = ROWOF(u);
                const float* krp;
                if (cache) { krp = krc + (size_t)row * 32; ko[m] = ((unsigned)((row >> 12) * 8 + hd) * KSL + (row & 4095)) * 96u; rr[m] = 1.f; }
                else {
                    rr[m] = ssq_zkv[row];
                    if (!samp) { krp = krc + OUT_KRP + ((size_t)l * MP + row) * 32; ko[m] = ((unsigned)((row >> 12) * 8 + hd) * 4096u + (row & 4095)) * 96u; }
                    else { const int rw = row - MP; krp = krc + OUT_KRS + ((size_t)l * MS + rw) * 32; ko[m] = ((unsigned)((rw >> 4) * 8 + hd) * KSL + 4096u + (rw & 15)) * 96u; }
                }
                k0[m] = *(const f32x4*)(krp + 8 * fq); k1[m] = *(const f32x4*)(krp + 8 * fq + 4);
            }
            const f32x4 g0 = *(const f32x4*)(gk + 8 * fq), g1 = *(const f32x4*)(gk + 8 * fq + 4), g2 = *(const f32x4*)(gk + 32 + 8 * fq), g3 = *(const f32x4*)(gk + 36 + 8 * fq),
                        g4 = *(const f32x4*)(gk + 64 + 8 * fq), g5 = *(const f32x4*)(gk + 68 + 8 * fq);
#pragma unroll
            for (int m = 0; m < 4; ++m) {
                const float r = cache ? 1.f : rsqrtf(rr[m] * (1.f / 256.f) + EPSF);
                const f32x4 v00 = acc[ai][0][m][0] * r, v01 = acc[ai][0][m][1] * r, v10 = acc[ai][1][m][0] * r, v11 = acc[ai][1][m][1] * r;
                const float s = red_fq(((ss4(v00) + ss4(v01)) + (ss4(v10) + ss4(v11))) + (ss4(k0[m]) + ss4(k1[m])));
                const float sc = rsqrtf(s * (1.f / 96.f) + EPSF);
                bf16_t* kd = kbase + ko[m];
                *(u32x4*)(kd + 8 * fq) = pack8(v00 * (g0 * sc), v01 * (g1 * sc));
                *(u32x4*)(kd + 32 + 8 * fq) = pack8(v10 * (g2 * sc), v11 * (g3 * sc));
                *(u32x4*)(kd + 64 + 8 * fq) = pack8(k0[m] * (g4 * sc), k1[m] * (g5 * sc));
            }
            FENCE();
        }
    }
};

struct EpiVT {
    static constexpr bool PERM = true;
    int l, cache;
    DEVI void operator()(AccRef acc, const Unit& u, int wr, int wc, int fr, int fq) const {
        unsigned char* ws = WSP();
        const float* ssq_zkv = (const float*)(ws + O_SSQZ) + (size_t)(5 + l) * MT;
        const bool samp = !cache && (u.pn * 256 >= MP);
        bf16_t* vbase = (bf16_t*)(ws + ((cache || samp) ? O_VTS : O_VTP));
        const unsigned ld = (cache || samp) ? KSL : 4096;
#pragma unroll
        for (int bj = 0; bj < 2; ++bj) {
            const int tok0 = u.pn * 256 + bj * 128 + wc * 32 + 8 * fq;
            f32x4 r0 = {1.f, 1.f, 1.f, 1.f}, r1 = r0;
            unsigned pos;
            if (!cache) {
                const f32x4 s0 = *(const f32x4*)(ssq_zkv + tok0), s1 = *(const f32x4*)(ssq_zkv + tok0 + 4);
#pragma unroll
                for (int j = 0; j < 4; ++j) { r0[j] = rsqrtf(s0[j] * (1.f / 256.f) + EPSF); r1[j] = rsqrtf(s1[j] * (1.f / 256.f) + EPSF); }
            }
            if (samp) { const int rr = tok0 - MP; pos = (unsigned)(rr >> 4) * 512u * ld + 4096u + ((rr & 8) ? 4u : 0u); }
            else pos = (unsigned)(tok0 >> 12) * 512u * ld + (unsigned)((tok0 & 4095) & ~15) + ((tok0 & 8) ? 4u : 0u);
            ROWLOOP {
                const int c = ROWOF(u);
                const f32x4 a = acc[ai][bj][m][0] * r0, b = acc[ai][bj][m][1] * r1;
                bf16_t* d = vbase + (pos + (unsigned)c * ld);
                u32x2 w0, w1; w0.x = cvtpk(a[0], a[1]); w0.y = cvtpk(a[2], a[3]); w1.x = cvtpk(b[0], b[1]); w1.y = cvtpk(b[2], b[3]);
                *(u32x2*)d = w0; *(u32x2*)(d + 8) = w1;
                FENCE();
            }
        }
    }
};

struct EpiGateB {
    static constexpr bool PERM = true;
    DEVI void operator()(AccRef acc, const Unit& u, int wr, int wc, int fr, int fq) const {
        bf16_t* gb = (bf16_t*)(WSP() + O_GB);
#pragma unroll
        for (int ai = 0; ai < 2; ++ai) {
            u32x4 w[4][2];
#pragma unroll
            for (int m = 0; m < 4; ++m)
#pragma unroll
                for (int bj = 0; bj < 2; ++bj) w[m][bj] = *(const u32x4*)(gb + (unsigned)ROWOF(u) * 1024u + u.pn * 256 + bj * 128 + wc * 32 + 8 * fq);
#pragma unroll
            for (int m = 0; m < 4; ++m)
#pragma unroll
                for (int bj = 0; bj < 2; ++bj)
                    *(u32x4*)(gb + (unsigned)ROWOF(u) * 1024u + u.pn * 256 + bj * 128 + wc * 32 + 8 * fq) = pack8(acc[ai][bj][m][0] * unpk_lo(w[m][bj]), acc[ai][bj][m][1] * unpk_hi(w[m][bj]));
            FENCE();
        }
    }
};
struct EpiGateA {
    static constexpr bool PERM = true;
    DEVI void operator()(AccRef acc, const Unit& u, int wr, int wc, int fr, int fq) const {
        unsigned char* ws = WSP();
        const bf16_t* ga = (const bf16_t*)(ws + O_GA); bf16_t* mb = (bf16_t*)(ws + O_GB);
#pragma unroll
        for (int ai = 0; ai < 2; ++ai) {
            u32x4 g[4][2], w[4][2];
#pragma unroll
            for (int m = 0; m < 4; ++m)
#pragma unroll
                for (int bj = 0; bj < 2; ++bj) { const unsigned off = (unsigned)ROWOF(u) * 1024u + u.pn * 256 + bj * 128 + wc * 32 + 8 * fq; g[m][bj] = *(const u32x4*)(ga + off); w[m][bj] = *(const u32x4*)(mb + off); }
#pragma unroll
            for (int m = 0; m < 4; ++m)
#pragma unroll
                for (int bj = 0; bj < 2; ++bj) { const unsigned off = (unsigned)ROWOF(u) * 1024u + u.pn * 256 + bj * 128 + wc * 32 + 8 * fq;
                    *(u32x4*)(mb + off) = pack8(acc[ai][bj][m][0] * unpk_lo(g[m][bj]) + unpk_lo(w[m][bj]), acc[ai][bj][m][1] * unpk_hi(g[m][bj]) + unpk_hi(w[m][bj])); }
            FENCE();
        }
    }
};
struct EpiRes {
    static constexpr bool PERM = true;
    int from_in, wxb, ssq_slot;
    DEVI void operator()(AccRef acc, const Unit& u, int wr, int wc, int fr, int fq) const {
        unsigned char* ws = WSP(); float* out = OUTP();
        const bool samp = u.pm * 256 >= MP;
        const float* base = from_in ? (samp ? IN(1) - (size_t)MP * 1024 : IN(0)) : out;
        bf16_t* xb = (bf16_t*)(ws + O_XB); float* ssq = (float*)(ws + O_SSQZ) + (size_t)ssq_slot * MT;
#pragma unroll
        for (int ai = 0; ai < 2; ++ai) {
            f32x4 b0[4][2], b1[4][2];
#pragma unroll
            for (int m = 0; m < 4; ++m)
#pragma unroll
                for (int bj = 0; bj < 2; ++bj) { const float* bp = base + (unsigned)ROWOF(u) * 1024u + u.pn * 256 + bj * 128 + wc * 32 + 8 * fq; b0[m][bj] = *(const f32x4*)bp; b1[m][bj] = *(const f32x4*)(bp + 4); }
#pragma unroll
            for (int m = 0; m < 4; ++m) {
                const int row = ROWOF(u);
                float s = 0.f;
#pragma unroll
                for (int bj = 0; bj < 2; ++bj) {
                    const unsigned off = (unsigned)row * 1024u + u.pn * 256 + bj * 128 + wc * 32 + 8 * fq;
                    const f32x4 o0 = b0[m][bj] + acc[ai][bj][m][0], o1 = b1[m][bj] + acc[ai][bj][m][1];
                    *(f32x4*)(out + off) = o0; *(f32x4*)(out + off + 4) = o1;
                    if (wxb) { *(u32x4*)(xb + off) = pack8(o0, o1); s += ss4(o0) + ss4(o1); }
                }
                if (wxb) { s = red_fq(s); if (fq == 0) unsafeAtomicAdd(ssq + row, s); }
            }
            FENCE();
        }
    }
};
struct EpiPartS {
    static constexpr bool PERM = true;
    DEVI void operator()(AccRef acc, const Unit& u, int wr, int wc, int fr, int fq) const {
        float* part = (float*)(WSP() + O_ZQ) + (size_t)u.ks * MS * 1024;
        ROWLOOP {
            const int row = ROWOF(u);
#pragma unroll
            for (int bj = 0; bj < 2; ++bj) {
                float* o = part + (unsigned)row * 1024u + u.pn * 256 + bj * 128 + wc * 32 + 8 * fq;
                *(f32x4*)o = acc[ai][bj][m][0]; *(f32x4*)(o + 4) = acc[ai][bj][m][1];
            }
        }
    }
};
struct EpiUp {
    static constexpr bool PERM = true;
    int l;
    DEVI void operator()(AccRef acc, const Unit& u, int wr, int wc, int fr, int fq) const {
        unsigned char* ws = WSP();
        const float* ssq = (const float*)(ws + O_SSQZ) + (size_t)(1 + l) * MT; bf16_t* ah = (bf16_t*)(ws + O_AH);
        ROWLOOP {
            const int row = ROWOF(u);
            const float r = rsqrtf(ssq[row] * (1.f / 1024.f) + EPSF);
#pragma unroll
            for (int bj = 0; bj < 2; ++bj) {
                f32x4 a = acc[ai][bj][m][0] * r, b = acc[ai][bj][m][1] * r;
#pragma unroll
                for (int j = 0; j < 4; ++j) { const float x = fmaxf(a[j], 0.f), y = fmaxf(b[j], 0.f); a[j] = x * x; b[j] = y * y; }
                *(u32x4*)(ah + (size_t)row * DFF + u.pn * 256 + bj * 128 + wc * 32 + 8 * fq) = pack8(a, b);
            }
        }
    }
};

constexpr int AT_KB = 64 * 208, AT_VB = 64 * 144, AT_TB = AT_KB + AT_VB;
#define MFMA32(a, b, c) __builtin_amdgcn_mfma_f32_32x32x16_bf16((a), (b), (c), 0, 0, 0)
template <bool SAMPLE>
DEVI void attn_unit(int wv, LAS unsigned char* lds, const bf16_t* Qb, const float* ssq_q, const bf16_t* Kb, const bf16_t* VTb, int ldv, int NT, int vis0, bf16_t* Ob) {
    const int tid = TID(), lane = tid & 63, r32 = lane & 31, hi = lane >> 5, w = __builtin_amdgcn_readfirstlane(tid >> 6);
    const int rloc = SAMPLE ? (r32 & 15) : 32 * w + r32;
    const int lastvis = SAMPLE ? NT : vis0 + (w >> 1);
    bf16x8 qr[6];
    {
        const float sq = rsqrtf(ssq_q[(size_t)rloc * 8] * (1.f / 96.f) + EPSF) * QSCALE;
#pragma unroll
        for (int d0 = 0; d0 < 6; ++d0) {
            const u32x4 wv = *(const u32x4*)(Qb + (size_t)rloc * 96 + 16 * d0 + 8 * hi);
            const u32x4 pk = pack8(unpk_lo(wv) * sq, unpk_hi(wv) * sq);
            qr[d0] = __builtin_bit_cast(bf16x8, pk);
        }
    }
    const int kp0 = tid, kp1 = 512 + tid;
    const int koff0 = (kp0 / 12) * 208 + (kp0 % 12) * 16, koff1 = (kp1 / 12) * 208 + (kp1 % 12) * 16;
    const int vd = tid >> 3, vc = tid & 7, voffl = AT_KB + vd * 144 + vc * 16;
    const bf16_t* vsrc = VTb + (size_t)vd * ldv + vc * 8;
    u32x4 kr0, kr1 = {0u, 0u, 0u, 0u}, vr;
#define AT_LOAD(t) do { kr0 = *(const u32x4*)(Kb + (size_t)(t) * 6144 + kp0 * 8); if (tid < 256) kr1 = *(const u32x4*)(Kb + (size_t)(t) * 6144 + kp1 * 8); vr = *(const u32x4*)(vsrc + (size_t)(t) * 64); } while (0)
#define AT_STORE(buf) do { LAS unsigned char* b_ = lds + (buf) * AT_TB; *(LAS u32x4*)(b_ + koff0) = kr0; if (tid < 256) *(LAS u32x4*)(b_ + koff1) = kr1; *(LAS u32x4*)(b_ + voffl) = vr; } while (0)
    float m_run = -INFINITY, l_run = 0.f;
    f32x16 o0, o1;
#pragma unroll
    for (int r = 0; r < 16; ++r) { o0[r] = 0.f; o1[r] = 0.f; }
    AT_LOAD(0); AT_STORE(0);
    __syncthreads();
    for (int t = 0; t < NT; ++t) {
        if (t + 1 < NT) AT_LOAD(t + 1);
        const bool active = SAMPLE ? ((t & 7) == w) : (t <= lastvis);
        if (active) {
            const LAS unsigned char* kb = lds + (t & 1) * AT_TB + r32 * 208 + hi * 16;
            const LAS unsigned char* vb = lds + (t & 1) * AT_TB + AT_KB + r32 * 144 + hi * 16;
            f32x16 p0, p1;
#pragma unroll
            for (int r = 0; r < 16; ++r) { p0[r] = 0.f; p1[r] = 0.f; }
#pragma unroll
            for (int d0 = 0; d0 < 6; ++d0) {
                const bf16x8 a0 = *(const LAS bf16x8*)(kb + d0 * 32), a1 = *(const LAS bf16x8*)(kb + 32 * 208 + d0 * 32);
                p0 = MFMA32(a0, qr[d0], p0); p1 = MFMA32(a1, qr[d0], p1);
            }
            if (SAMPLE && t == NT - 1) {
#pragma unroll
                for (int r = 0; r < 16; ++r) { if (r >= 8) p0[r] = -INFINITY; p1[r] = -INFINITY; }
            }
            float mx = fmaxf(p0[0], p1[0]);
#pragma unroll
            for (int r = 1; r < 16; ++r) mx = fmaxf(mx, fmaxf(p0[r], p1[r]));
            mx = fmaxf(mx, __shfl_xor(mx, 32));
            const float mn = fmaxf(m_run, mx), alpha = __builtin_amdgcn_exp2f(m_run - mn);
            m_run = mn;
            float rs = 0.f;
#pragma unroll
            for (int r = 0; r < 16; ++r) { p0[r] = __builtin_amdgcn_exp2f(p0[r] - mn); p1[r] = __builtin_amdgcn_exp2f(p1[r] - mn); rs += p0[r] + p1[r]; }
            l_run = l_run * alpha + rs;
#pragma unroll
            for (int r = 0; r < 16; ++r) { o0[r] *= alpha; o1[r] *= alpha; }
            u32x4 pw[4];
#pragma unroll
            for (int s = 0; s < 2; ++s) {
                pw[s] = (u32x4){cvtpk(p0[8 * s], p0[8 * s + 1]), cvtpk(p0[8 * s + 2], p0[8 * s + 3]), cvtpk(p0[8 * s + 4], p0[8 * s + 5]), cvtpk(p0[8 * s + 6], p0[8 * s + 7])};
                pw[2 + s] = (u32x4){cvtpk(p1[8 * s], p1[8 * s + 1]), cvtpk(p1[8 * s + 2], p1[8 * s + 3]), cvtpk(p1[8 * s + 4], p1[8 * s + 5]), cvtpk(p1[8 * s + 6], p1[8 * s + 7])};
            }
#pragma unroll
            for (int ks = 0; ks < 4; ++ks) {
                const bf16x8 va = *(const LAS bf16x8*)(vb + ks * 32), vb2 = *(const LAS bf16x8*)(vb + 32 * 144 + ks * 32);
                const bf16x8 pb = __builtin_bit_cast(bf16x8, pw[ks]);
                o0 = MFMA32(va, pb, o0); o1 = MFMA32(vb2, pb, o1);
            }
        }
        if (t + 1 < NT) AT_STORE((t + 1) & 1);
        __syncthreads();
    }
#undef AT_LOAD
#undef AT_STORE
    const float lt = l_run + __shfl_xor(l_run, 32);
    if (!SAMPLE) {
        const float inv = 1.f / lt;
        bf16_t* od = Ob + (size_t)rloc * 512 + 4 * hi;
#pragma unroll
        for (int rg = 0; rg < 4; ++rg) {
            u32x2 a, b; a.x = cvtpk(o0[4 * rg] * inv, o0[4 * rg + 1] * inv); a.y = cvtpk(o0[4 * rg + 2] * inv, o0[4 * rg + 3] * inv);
            b.x = cvtpk(o1[4 * rg] * inv, o1[4 * rg + 1] * inv); b.y = cvtpk(o1[4 * rg + 2] * inv, o1[4 * rg + 3] * inv);
            *(u32x2*)(od + 8 * rg) = a; *(u32x2*)(od + 32 + 8 * rg) = b;
        }
    } else {
        LAS float* cm = (LAS float*)lds; LAS float* cl = cm + 128; LAS float* co = cm + 256;
        if (r32 < 16) {
            if (hi == 0) { cm[w * 16 + r32] = m_run; cl[w * 16 + r32] = lt; }
#pragma unroll
            for (int r = 0; r < 16; ++r) { const int d = (r & 3) + 8 * (r >> 2) + 4 * hi; co[(w * 16 + r32) * 64 + d] = o0[r]; co[(w * 16 + r32) * 64 + 32 + d] = o1[r]; }
        }
        __syncthreads();
        {
            const int q = tid >> 5, dp = (tid & 31) * 2;
            float M = cm[q];
#pragma unroll
            for (int ww = 1; ww < 8; ++ww) M = fmaxf(M, cm[ww * 16 + q]);
            float L = 0.f, x0 = 0.f, x1 = 0.f;
#pragma unroll
            for (int ww = 0; ww < 8; ++ww) { const float f = __builtin_amdgcn_exp2f(cm[ww * 16 + q] - M); L += f * cl[ww * 16 + q]; x0 += f * co[(ww * 16 + q) * 64 + dp]; x1 += f * co[(ww * 16 + q) * 64 + dp + 1]; }
            const float inv = 1.f / L;
            *(unsigned*)(Ob + (size_t)q * 512 + dp) = cvtpk(x0 * inv, x1 * inv);
        }
        __syncthreads();
    }
}


DEVI void at_compute(const LAS unsigned char* tb, int r32, int hi, const bf16x8 (&qr)[6], bool first, f32x16& negm, float& m_ref, float& l_run, f32x16& o0, f32x16& o1) {
    const LAS unsigned char* kb = tb + r32 * 208 + hi * 16;
    const LAS unsigned char* vb = tb + AT_KB + r32 * 144 + hi * 16;
    f32x16 p0 = negm, p1 = negm;
    bf16x8 kf[12];
#pragma unroll
    for (int d0 = 0; d0 < 6; ++d0) { kf[2 * d0] = *(const LAS bf16x8*)(kb + d0 * 32); kf[2 * d0 + 1] = *(const LAS bf16x8*)(kb + 32 * 208 + d0 * 32); }
    __builtin_amdgcn_sched_barrier(0);
    __builtin_amdgcn_s_setprio(1);
#pragma unroll
    for (int d0 = 0; d0 < 6; ++d0) { p0 = MFMA32(kf[2 * d0], qr[d0], p0); p1 = MFMA32(kf[2 * d0 + 1], qr[d0], p1); }
    __builtin_amdgcn_s_setprio(0);
    bf16x8 vf[8];
#pragma unroll
    for (int ks = 0; ks < 4; ++ks) { vf[2 * ks] = *(const LAS bf16x8*)(vb + ks * 32); vf[2 * ks + 1] = *(const LAS bf16x8*)(vb + 32 * 144 + ks * 32); }
    __builtin_amdgcn_sched_barrier(0);
    asm volatile("s_nop 15\n\ts_nop 7" : "+v"(p0), "+v"(p1));
    float mxa = max3a(p0[0], p0[1], p1[0]), mxb = max3a(p0[2], p0[3], p1[1]);
    mxa = max3a(mxa, p1[2], p1[3]);
#pragma unroll
    for (int r = 4; r < 16; r += 4) { mxa = max3a(mxa, p0[r], p0[r + 1]); mxb = max3a(mxb, p0[r + 2], p0[r + 3]); mxa = max3a(mxa, p1[r], p1[r + 1]); mxb = max3a(mxb, p1[r + 2], p1[r + 3]); }
    float mx = max2a(mxa, mxb);
    mx = max2a(mx, __shfl_xor(mx, 32));
    if (first || __any(mx > 8.f)) {
        const float d = first ? mx : max2a(mx, 0.f);
        m_ref += d;
        const float alpha = first ? 1.f : __builtin_amdgcn_exp2f(-d);
        l_run *= alpha;
#pragma unroll
        for (int r = 0; r < 16; ++r) { p0[r] -= d; p1[r] -= d; negm[r] -= d; o0[r] *= alpha; o1[r] *= alpha; }
    }
    float rs = 0.f;
#pragma unroll
    for (int r = 0; r < 16; ++r) { p0[r] = __builtin_amdgcn_exp2f(p0[r]); p1[r] = __builtin_amdgcn_exp2f(p1[r]); rs += p0[r] + p1[r]; }
    l_run += rs;
    u32x4 pw[4];
#pragma unroll
    for (int s = 0; s < 2; ++s) {
        pw[s] = (u32x4){cvtpk(p0[8 * s], p0[8 * s + 1]), cvtpk(p0[8 * s + 2], p0[8 * s + 3]), cvtpk(p0[8 * s + 4], p0[8 * s + 5]), cvtpk(p0[8 * s + 6], p0[8 * s + 7])};
        pw[2 + s] = (u32x4){cvtpk(p1[8 * s], p1[8 * s + 1]), cvtpk(p1[8 * s + 2], p1[8 * s + 3]), cvtpk(p1[8 * s + 4], p1[8 * s + 5]), cvtpk(p1[8 * s + 6], p1[8 * s + 7])};
    }
    __builtin_amdgcn_s_setprio(1);
#pragma unroll
    for (int ks = 0; ks < 4; ++ks) {
        const bf16x8 pb = __builtin_bit_cast(bf16x8, pw[ks]);
        o0 = MFMA32(vf[2 * ks], pb, o0); o1 = MFMA32(vf[2 * ks + 1], pb, o1);
    }
    __builtin_amdgcn_s_setprio(0);
}
DEVI void attn_unit_p(int wv, LAS unsigned char* lds, const bf16_t* Qb, const float* ssq_q, const bf16_t* Kb, const bf16_t* VTb, int ldv, int NT, int vis0, bf16_t* Ob) {
    const int tid = TID(), lane = tid & 63, r32 = lane & 31, hi = lane >> 5, w = __builtin_amdgcn_readfirstlane(tid >> 6);
    const int rloc = 32 * w + r32;
    const int lastvis = vis0 + (w >> 1);
    bf16x8 qr[6];
    {
        const float sq = rsqrtf(ssq_q[(size_t)rloc * 8] * (1.f / 96.f) + EPSF) * QSCALE;
#pragma unroll
        for (int d0 = 0; d0 < 6; ++d0) {
            const u32x4 wq = *(const u32x4*)(Qb + (size_t)rloc * 96 + 16 * d0 + 8 * hi);
            const u32x4 pk = pack8(unpk_lo(wq) * sq, unpk_hi(wq) * sq);
            qr[d0] = __builtin_bit_cast(bf16x8, pk);
        }
    }
    const int kp0 = tid, kp1 = 512 + tid;
    const int koff0 = (kp0 / 12) * 208 + (kp0 % 12) * 16, koff1 = (kp1 / 12) * 208 + (kp1 % 12) * 16;
    const int vd = tid >> 3, vc = tid & 7, voffl = AT_KB + vd * 144 + vc * 16;
    const bf16_t* vsrc = VTb + (size_t)vd * ldv + vc * 8;
    const bool two = tid < 256;
    u32x4 ka0, ka1 = {0u, 0u, 0u, 0u}, va, kb0, kb1 = {0u, 0u, 0u, 0u}, vbb;
#define AT_LD(K0, K1, V, t) do { K0 = *(const u32x4*)(Kb + (size_t)(t) * 6144 + kp0 * 8); if (two) K1 = *(const u32x4*)(Kb + (size_t)(t) * 6144 + kp1 * 8); V = *(const u32x4*)(vsrc + (size_t)(t) * 64); } while (0)
#define AT_ST(K0, K1, V, buf) do { LAS unsigned char* b_ = lds + (buf) * AT_TB; *(LAS u32x4*)(b_ + koff0) = K0; if (two) *(LAS u32x4*)(b_ + koff1) = K1; *(LAS u32x4*)(b_ + voffl) = V; } while (0)
    float m_run = 0.f, l_run = 0.f;
    f32x16 o0, o1, negm;
#pragma unroll
    for (int r = 0; r < 16; ++r) { o0[r] = 0.f; o1[r] = 0.f; negm[r] = 0.f; }
    AT_LD(kb0, kb1, vbb, 0); AT_LD(ka0, ka1, va, 1);
    AT_ST(kb0, kb1, vbb, 0);
    __syncthreads();
    for (int t = 0; t < NT; t += 2) {
        if (t + 2 < NT) AT_LD(kb0, kb1, vbb, t + 2);
        if (t <= lastvis) at_compute(lds, r32, hi, qr, t == 0, negm, m_run, l_run, o0, o1);
        AT_ST(ka0, ka1, va, 1);
        __syncthreads();
        if (t + 3 < NT) AT_LD(ka0, ka1, va, t + 3);
        if (t + 1 <= lastvis) at_compute(lds + AT_TB, r32, hi, qr, false, negm, m_run, l_run, o0, o1);
        if (t + 2 < NT) AT_ST(kb0, kb1, vbb, 0);
        __syncthreads();
    }
#undef AT_LD
#undef AT_ST
    const float lt = l_run + __shfl_xor(l_run, 32);
    const float inv = 1.f / lt;
    bf16_t* od = Ob + (size_t)rloc * 512 + 4 * hi;
#pragma unroll
    for (int rg = 0; rg < 4; ++rg) {
        u32x2 a, b; a.x = cvtpk(o0[4 * rg] * inv, o0[4 * rg + 1] * inv); a.y = cvtpk(o0[4 * rg + 2] * inv, o0[4 * rg + 3] * inv);
        b.x = cvtpk(o1[4 * rg] * inv, o1[4 * rg + 1] * inv); b.y = cvtpk(o1[4 * rg + 2] * inv, o1[4 * rg + 3] * inv);
        *(u32x2*)(od + 8 * rg) = a; *(u32x2*)(od + 32 + 8 * rg) = b;
    }
}

constexpr int FS_PITCH = 528, FS_W = 64 * FS_PITCH, FS_COMB = 2 * FS_W, FS_NBLK = 129;
DEVI bf16x8 pk_regs(const f32x16& x, int s, float sc) {
    u32x4 w; w.x = cvtpk(x[8 * s] * sc, x[8 * s + 1] * sc); w.y = cvtpk(x[8 * s + 2] * sc, x[8 * s + 3] * sc); w.z = cvtpk(x[8 * s + 4] * sc, x[8 * s + 5] * sc); w.w = cvtpk(x[8 * s + 6] * sc, x[8 * s + 7] * sc);
    return __builtin_bit_cast(bf16x8, w);
}
DEVI void sample_attn_fused(int wv, LAS unsigned char* lds, int l, int bh) {
    const int tid = TID(), lane = tid & 63, r32 = lane & 31, hi = lane >> 5, w = __builtin_amdgcn_readfirstlane(tid >> 6);
    const int b = bh >> 3, h = bh & 7;
    unsigned char* ws = WSP();
    {
        const bf16_t* wk = (const bf16_t*)(ws + O_W + (size_t)l * W_LAYER + W_KC); const bf16_t* wvv = (const bf16_t*)(ws + O_W + (size_t)l * W_LAYER + W_VC);
        for (int i = tid; i < 4096; i += 512) {
            const int mat = i >> 11, rem = i & 2047, d = rem >> 5, ch = rem & 31;
            const int srow = mat == 0 ? 256 * (h >> 2) + 128 * (d >> 5) + 32 * (h & 3) + (d & 31) : h * 64 + d;
            const u32x4 v = *(const u32x4*)((mat == 0 ? wk : wvv) + (size_t)srow * 256 + ch * 8);
            *(LAS u32x4*)(lds + mat * FS_W + d * FS_PITCH + ch * 16) = v;
        }
    }
    LAS bf16x8* qf = (LAS bf16x8*)(lds + FS_COMB + 34816) + lane;
    {
        bf16x8 qn[4], qrp[2];
        const int qrow = r32 & 15; const size_t tokrow = (size_t)MP + b * 16 + qrow;
        const bf16_t* Qb = (const bf16_t*)(ws + O_QS) + ((size_t)bh * 16 + qrow) * 96;
        const float* gk = IN(12) + l * 96;
        const float sq = rsqrtf(((const float*)(ws + O_SSQZ) + (size_t)(7 + 8 * l) * MT)[tokrow * 8 + h] * (1.f / 96.f) + EPSF) * QSCALE;
#pragma unroll
        for (int f = 0; f < 4; ++f) {
            const int d0 = 32 * (f >> 1) + 16 * (f & 1) + 4 * hi;
            const u32x2 a = *(const u32x2*)(Qb + d0), c = *(const u32x2*)(Qb + d0 + 8);
            const f32x4 ga = *(const f32x4*)(gk + d0) * sq, gc = *(const f32x4*)(gk + d0 + 8) * sq;
            u32x4 pk; pk.x = cvtpk(bflo(a.x) * ga[0], bfhi(a.x) * ga[1]); pk.y = cvtpk(bflo(a.y) * ga[2], bfhi(a.y) * ga[3]);
            pk.z = cvtpk(bflo(c.x) * gc[0], bfhi(c.x) * gc[1]); pk.w = cvtpk(bflo(c.y) * gc[2], bfhi(c.y) * gc[3]);
            qn[f] = __builtin_bit_cast(bf16x8, pk);
        }
#pragma unroll
        for (int s = 0; s < 2; ++s) {
            const int d0 = 64 + 16 * s + 8 * hi;
            const u32x4 a = *(const u32x4*)(Qb + d0);
            const f32x4 g0 = *(const f32x4*)(gk + d0) * sq, g1 = *(const f32x4*)(gk + d0 + 4) * sq;
            const u32x4 pk = pack8(unpk_lo(a) * g0, unpk_hi(a) * g1);
            qrp[s] = __builtin_bit_cast(bf16x8, pk);
        }
        if (w == 0) { qf[0] = qn[0]; qf[64] = qn[1]; qf[128] = qn[2]; qf[192] = qn[3]; qf[256] = qrp[0]; qf[320] = qrp[1]; }
    }
    __syncthreads();
    const bf16_t* cache_c = (const bf16_t*)(ws + O_CKVB) + ((size_t)l * MC + (size_t)b * 4096) * 256;
    const float* cache_r = IN(3) + ((size_t)l * MC + (size_t)b * 4096) * 32;
    const bf16_t* new_c = (const bf16_t*)(ws + O_CKVN) + (size_t)(b * 16 + (r32 & 15)) * 256;
    const float* new_r = OUTP() + OUT_KRS + ((size_t)l * MS + b * 16 + (r32 & 15)) * 32;
#define FS_CP(kb) ((kb) < 128 ? cache_c + (size_t)((kb) * 32 + r32) * 256 + 32 * hi : new_c + 32 * hi)
#define FS_KO(ks) (64 * ((ks) >> 2) + 8 * ((ks) & 3))
#define FS_RP(kb) ((kb) < 128 ? cache_r + (size_t)((kb) * 32 + r32) * 32 + 8 * hi : new_r + 8 * hi)
    bf16x8 cf[16]; f32x4 kr0, kr1, kr2, kr3;
    {
        const bf16_t* cp = FS_CP(w); const float* rp = FS_RP(w);
#pragma unroll
        for (int ks = 0; ks < 16; ++ks) cf[ks] = *(const bf16x8*)(cp + FS_KO(ks));
        kr0 = *(const f32x4*)rp; kr1 = *(const f32x4*)(rp + 4); kr2 = *(const f32x4*)(rp + 16); kr3 = *(const f32x4*)(rp + 20);
    }
    float m_run = -INFINITY, l_run = 0.f;
    f32x16 o0, o1;
#pragma unroll
    for (int r = 0; r < 16; ++r) { o0[r] = 0.f; o1[r] = 0.f; }
    const LAS unsigned char* wkl = lds + r32 * FS_PITCH + hi * 64;
    const LAS unsigned char* wvl = lds + FS_W + r32 * FS_PITCH + hi * 64;
#pragma unroll 1
    for (int kb = w; kb < FS_NBLK; kb += 8) {
        const int nkb = kb + 8; const bool more = nkb < FS_NBLK;
        const bf16_t* ncp = FS_CP(more ? nkb : kb); const float* nrp = FS_RP(more ? nkb : kb);
        f32x16 x0, x1;
#pragma unroll
        for (int r = 0; r < 16; ++r) { x0[r] = 0.f; x1[r] = 0.f; }
#pragma unroll
        for (int ks = 0; ks < 16; ++ks) {
            const bf16x8 a0 = *(const LAS bf16x8*)(wkl + 2 * FS_KO(ks)), a1 = *(const LAS bf16x8*)(wkl + 32 * FS_PITCH + 2 * FS_KO(ks));
            x0 = MFMA32(a0, cf[ks], x0); x1 = MFMA32(a1, cf[ks], x1);
            if ((ks & 3) == 3) __builtin_amdgcn_sched_barrier(0);
        }
        float ss = (ss4(kr0) + ss4(kr1)) + (ss4(kr2) + ss4(kr3));
#pragma unroll
        for (int r = 0; r < 16; ++r) ss += x0[r] * x0[r] + x1[r] * x1[r];
        ss += __shfl_xor(ss, 32);
        const float sk = rsqrtf(ss * (1.f / 96.f) + EPSF);
        f32x16 p;
#pragma unroll
        for (int r = 0; r < 16; ++r) p[r] = 0.f;
        p = MFMA32(pk_regs(x0, 0, sk), qf[0], p); p = MFMA32(pk_regs(x0, 1, sk), qf[64], p);
        p = MFMA32(pk_regs(x1, 0, sk), qf[128], p); p = MFMA32(pk_regs(x1, 1, sk), qf[192], p);
        { const u32x4 k0 = pack8(kr0 * sk, kr1 * sk), k1 = pack8(kr2 * sk, kr3 * sk);
          p = MFMA32(__builtin_bit_cast(bf16x8, k0), qf[256], p); p = MFMA32(__builtin_bit_cast(bf16x8, k1), qf[320], p); }
        if (more) { kr0 = *(const f32x4*)nrp; kr1 = *(const f32x4*)(nrp + 4); kr2 = *(const f32x4*)(nrp + 16); kr3 = *(const f32x4*)(nrp + 20); }
        if (kb == 128) {
#pragma unroll
            for (int r = 8; r < 16; ++r) p[r] = -INFINITY;
        }
        float mx = p[0];
#pragma unroll
        for (int r = 1; r < 16; ++r) mx = fmaxf(mx, p[r]);
        mx = fmaxf(mx, __shfl_xor(mx, 32));
        const float mn = fmaxf(m_run, mx), alpha = __builtin_amdgcn_exp2f(m_run - mn);
        m_run = mn;
        float rs = 0.f;
#pragma unroll
        for (int r = 0; r < 16; ++r) { p[r] = __builtin_amdgcn_exp2f(p[r] - mn); rs += p[r]; }
        l_run = l_run * alpha + rs;
#pragma unroll
        for (int r = 0; r < 16; ++r) { o0[r] *= alpha; o1[r] *= alpha; }
        const bf16x8 pb0 = pk_regs(p, 0, 1.f), pb1 = pk_regs(p, 1, 1.f);
        {
            f32x16 v;
#pragma unroll
            for (int r = 0; r < 16; ++r) v[r] = 0.f;
#pragma unroll
            for (int ks = 0; ks < 16; ++ks) { v = MFMA32(cf[ks], *(const LAS bf16x8*)(wvl + 2 * FS_KO(ks)), v); if ((ks & 3) == 3) __builtin_amdgcn_sched_barrier(0); }
            o0 = MFMA32(pk_regs(v, 0, 1.f), pb0, o0); o0 = MFMA32(pk_regs(v, 1, 1.f), pb1, o0);
        }
        {
            f32x16 v;
#pragma unroll
            for (int r = 0; r < 16; ++r) v[r] = 0.f;
#pragma unroll
            for (int ks = 0; ks < 16; ++ks) {
                v = MFMA32(cf[ks], *(const LAS bf16x8*)(wvl + 32 * FS_PITCH + 2 * FS_KO(ks)), v);
                if (more) cf[ks] = *(const bf16x8*)(ncp + FS_KO(ks));
                if ((ks & 3) == 3) __builtin_amdgcn_sched_barrier(0);
            }
            o1 = MFMA32(pk_regs(v, 0, 1.f), pb0, o1); o1 = MFMA32(pk_regs(v, 1, 1.f), pb1, o1);
        }
    }
#undef FS_CP
#undef FS_KO
#undef FS_RP
    const float lt = l_run + __shfl_xor(l_run, 32);
    LAS float* cm = (LAS float*)(lds + FS_COMB); LAS float* cl = cm + 128; LAS float* co = cm + 256;
    if (r32 < 16) {
        if (hi == 0) { cm[w * 16 + r32] = m_run; cl[w * 16 + r32] = lt; }
#pragma unroll
        for (int r = 0; r < 16; ++r) { const int d = (r & 3) + 8 * (r >> 2) + 4 * hi; co[(w * 16 + r32) * 64 + d] = o0[r]; co[(w * 16 + r32) * 64 + 32 + d] = o1[r]; }
    }
    __syncthreads();
    {
        const int q = tid >> 5, dp = (tid & 31) * 2;
        float M = cm[q];
#pragma unroll
        for (int ww = 1; ww < 8; ++ww) M = fmaxf(M, cm[ww * 16 + q]);
        float L = 0.f, y0 = 0.f, y1 = 0.f;
#pragma unroll
        for (int ww = 0; ww < 8; ++ww) { const float f = __builtin_amdgcn_exp2f(cm[ww * 16 + q] - M); L += f * cl[ww * 16 + q]; y0 += f * co[(ww * 16 + q) * 64 + dp]; y1 += f * co[(ww * 16 + q) * 64 + dp + 1]; }
        const float inv = 1.f / L;
        *(unsigned*)((bf16_t*)(ws + O_ATT) + ((size_t)MP + b * 16 + q) * 512 + h * 64 + dp) = cvtpk(y0 * inv, y1 * inv);
    }
    __syncthreads();
}
static_assert(FS_COMB + 34816 + 6 * 64 * 16 <= LDS_BYTES && (256 + 8 * 16 * 64) * 4 <= 34816, "fused sample attention LDS");

struct Args { const float* in[21]; float* out; unsigned char* ws; };

__device__ const double ROPE_INV[16] = {1.0, 0.5623413251903491, 0.31622776601683794, 0.1778279410038923, 0.1, 0.05623413251903491, 0.03162277660168379, 0.01778279410038923, 0.01, 0.005623413251903491,
                                        0.0031622776601683794, 0.0017782794100389228, 0.001, 0.0005623413251903491, 0.00031622776601683794, 0.00017782794100389227};

DEVI void tr_item(const float* W, int N, int K, const float* gain, bf16_t* WT, int dest0, LAS float* scr, int k0, int n0, int lane) {
#pragma unroll
    for (int i = 0; i < 32; ++i) { const int kk = 2 * i + (lane >> 5); float v = W[(size_t)(k0 + kk) * N + n0 + (lane & 31)]; if (gain) v *= gain[k0 + kk]; scr[kk * 33 + (lane & 31)] = v; }
    asm volatile("s_waitcnt lgkmcnt(0)" ::: "memory");
    const int c = lane & 7;
#pragma unroll
    for (int j = 0; j < 4; ++j) { const int n = (lane >> 3) + 8 * j; const LAS float* s = scr + (8 * c) * 33 + n;
        u32x4 o; o.x = cvtpk(s[0], s[33]); o.y = cvtpk(s[2 * 33], s[3 * 33]); o.z = cvtpk(s[4 * 33], s[5 * 33]); o.w = cvtpk(s[6 * 33], s[7 * 33]);
        *(u32x4*)(WT + (size_t)(dest0 + n) * K + k0 + 8 * c) = o; }
    asm volatile("s_waitcnt lgkmcnt(0)" ::: "memory");
}


template <class Epi>
DEVI void run_gemm(int wv, LAS unsigned char* lds, const bf16_t* A, const bf16_t* Bt, int lda, int ldb, int M, int N, int K, int& off, const Epi& E, int nNr = 0) {
    const int G = GDIM();
    pg8::Gemm g{A, Bt, lda, ldb, K, nNr};
    pg8::StaticOrder S; S.init(M, N, G, (int)((BID() + G - (off % G)) % G));
    pg8::gemm_phase<Epi, pg8::StaticOrder>(wv, lds, g, S, E);
    off += (M / 256) * (N / 256);
}

DEVI void prologue(int wv, LAS unsigned char* lds) {
    const int tid = TID(), lane = tid & 63, wave = __builtin_amdgcn_readfirstlane(tid >> 6);
    const int G = GDIM(), bx = BID();
    const int gw = bx * 8 + wave, NGW = G * 8;
    const size_t gt = (size_t)bx * 512 + tid, NGT = (size_t)G * 512;
    unsigned char* ws = WSP();
    LAS float* scr = (LAS float*)(lds + wave * 8448);
    constexpr int I_IN = 16 * 101, I_UQ = 6 * 24, I_KV = 4 * 32, I_A = 8 * 32, I_O = 16 * 32, I_UP = 16 * 128, I_DN = 64 * 32;
    constexpr int I_L = I_IN + I_UQ + 2 * I_KV + I_A + I_O + I_UP + I_DN;
    for (int it = gw; it < 2 * I_L; it += NGW) {
        const int l = it / I_L; int r = it % I_L;
        unsigned char* wl = ws + O_W + (size_t)l * W_LAYER;
        if (r < I_IN) { const int kb = r / 101, nb = r % 101, n0 = nb * 32;
            const int d0 = n0 < 384 ? n0 : n0 < 640 ? 512 + (n0 - 384) : n0 < 672 ? 384 + (n0 - 640) : n0 < 1184 ? 768 + (n0 - 672) : n0 < 2208 ? 1280 + (n0 - 1184) : 2304 + (n0 - 2208);
            tr_item(IN(6) + (size_t)l * 1024 * 3232, 3232, 1024, IN(5) + l * 1024, (bf16_t*)(wl + W_IN), d0, scr, kb * 64, n0, lane); continue; }
        r -= I_IN;
        if (r < I_UQ) { const int kb = r / 24, nb = r % 24, n0 = nb * 32, hd = n0 / 96, dim0 = n0 % 96;
            const int d0 = dim0 < 64 ? 256 * (hd >> 2) + 128 * (dim0 >> 5) + 32 * (hd & 3) : 512 + 128 * (hd >> 2) + 32 * (hd & 3);
            tr_item(IN(9) + (size_t)l * 384 * 768, 768, 384, IN(7) + l * 384, (bf16_t*)(wl + W_UQ), d0, scr, kb * 64, n0, lane); continue; }
        r -= I_UQ;
        if (r < 2 * I_KV) { const int fold = r < I_KV; if (!fold) r -= I_KV;
            const int kb = r / 32, nb = r % 32, n0 = nb * 32, hd = n0 / 128, dim0 = n0 % 128;
            const bool isk = dim0 < 64;
            const int d0 = isk ? 256 * (hd >> 2) + 128 * (dim0 >> 5) + 32 * (hd & 3) : hd * 64 + (dim0 - 64);
            bf16_t* dst = (bf16_t*)(wl + (fold ? (isk ? W_K : W_V) : (isk ? W_KC : W_VC)));
            tr_item(IN(10) + (size_t)l * 256 * 1024, 1024, 256, fold ? IN(8) + l * 256 : nullptr, dst, d0, scr, kb * 64, n0, lane); continue; }
        r -= 2 * I_KV;
        if (r < I_A) { tr_item(IN(13) + (size_t)l * 512 * 1024, 1024, 512, nullptr, (bf16_t*)(wl + W_A), (r % 32) * 32, scr, (r / 32) * 64, (r % 32) * 32, lane); continue; }
        r -= I_A;
        if (r < I_O) { tr_item(IN(17) + (size_t)l * 1024 * 1024, 1024, 1024, nullptr, (bf16_t*)(wl + W_O), (r % 32) * 32, scr, (r / 32) * 64, (r % 32) * 32, lane); continue; }
        r -= I_O;
        if (r < I_UP) { tr_item(IN(19) + (size_t)l * 1024 * 4096, 4096, 1024, IN(18) + l * 1024, (bf16_t*)(wl + W_UP), (r % 128) * 32, scr, (r / 128) * 64, (r % 128) * 32, lane); continue; }
        r -= I_UP;
        tr_item(IN(20) + (size_t)l * 4096 * 1024, 1024, 4096, nullptr, (bf16_t*)(wl + W_DN), (r % 32) * 32, scr, (r / 32) * 64, (r % 32) * 32, lane);
    }
    for (size_t i = gt; i < (size_t)2 * 96 * 1024 / 8; i += NGT) { const size_t l = i / (96 * 128), rem = i % (96 * 128);
        *(u32x4*)(ws + O_W + l * W_LAYER + W_IN + ((size_t)416 * 1024) * 2 + rem * 16) = (u32x4){0u, 0u, 0u, 0u}; }
    {
        const float* wpool = IN(14); const float* pscale = IN(15); const float* wpo = IN(16);
        for (size_t it = gt; it < (size_t)2 * 65536; it += NGT) {
            const int l = (int)(it >> 16), r = (int)(it & 65535), kc = r >> 10, n = r & 1023, g = kc >> 4, c0 = (kc & 15) * 8;
            const float* wp = wpool + (size_t)l * 4 * 128 * 128 + ((size_t)g * 128 + c0) * 128;
            const float* ps = pscale + l * 512 + g * 128;
            const float* wo = wpo + (size_t)l * 512 * 1024 + (size_t)g * 128 * 1024 + n;
            float a0 = 0.f, a1 = 0.f, a2 = 0.f, a3 = 0.f, a4 = 0.f, a5 = 0.f, a6 = 0.f, a7 = 0.f;
#pragma unroll 16
            for (int e = 0; e < 128; ++e) { const float x = wo[(size_t)e * 1024] * ps[e];
                a0 += wp[e] * x; a1 += wp[128 + e] * x; a2 += wp[256 + e] * x; a3 += wp[384 + e] * x; a4 += wp[512 + e] * x; a5 += wp[640 + e] * x; a6 += wp[768 + e] * x; a7 += wp[896 + e] * x; }
            u32x4 o; o.x = cvtpk(a0, a1); o.y = cvtpk(a2, a3); o.z = cvtpk(a4, a5); o.w = cvtpk(a6, a7);
            *(u32x4*)((bf16_t*)(ws + O_W + (size_t)l * W_LAYER + W_EFF) + (size_t)n * 512 + g * 128 + c0) = o;
        }
    }
    {
        const float* x_p = IN(0); const float* x_s = IN(1); bf16_t* xb = (bf16_t*)(ws + O_XB); float* ssqA0 = (float*)(ws + O_SSQA0);
        for (int row0 = gw; row0 < MT; row0 += 4 * NGW) {
            f32x4 v[4][4];
#pragma unroll
            for (int k = 0; k < 4; ++k) { const int row = row0 + k * NGW;
                if (row < MT) { const float* xr = row < MP ? x_p + (size_t)row * 1024 : x_s + (size_t)(row - MP) * 1024;
#pragma unroll
                    for (int j = 0; j < 4; ++j) v[k][j] = *(const f32x4*)(xr + 256 * j + 4 * lane); } }
#pragma unroll
            for (int k = 0; k < 4; ++k) { const int row = row0 + k * NGW;
                if (row < MT) { float s = 0.f;
#pragma unroll
                    for (int j = 0; j < 4; ++j) { s += ss4(v[k][j]); u32x2 o; o.x = cvtpk(v[k][j][0], v[k][j][1]); o.y = cvtpk(v[k][j][2], v[k][j][3]); *(u32x2*)(xb + (size_t)row * 1024 + 256 * j + 4 * lane) = o; }
#pragma unroll
                    for (int o = 1; o < 64; o <<= 1) s += __shfl_xor(s, o);
                    if (lane == 0) ssqA0[row] = s; } }
        }
    }
    {
        const float* cache_ckv = IN(2); bf16_t* ckvb = (bf16_t*)(ws + O_CKVB);
        for (size_t i = gt; i < (size_t)2 * MC * 256 / 8; i += 8 * NGT) {
            f32x4 a[8], b[8];
#pragma unroll
            for (int k = 0; k < 8; ++k) { const size_t ii = i + k * NGT; if (ii < (size_t)2 * MC * 256 / 8) { a[k] = *(const f32x4*)(cache_ckv + ii * 8); b[k] = *(const f32x4*)(cache_ckv + ii * 8 + 4); } }
#pragma unroll
            for (int k = 0; k < 8; ++k) { const size_t ii = i + k * NGT; if (ii < (size_t)2 * MC * 256 / 8) *(u32x4*)(ckvb + ii * 8) = pack8(a[k], b[k]); }
        }
    }
    { float* ssqz = (float*)(ws + O_SSQZ); for (size_t i = gt; i < SSQZ_FLOATS; i += NGT) ssqz[i] = 0.f; }
}

DEVI void thin_rows(int wv, int l) {
    const int tid = TID(), lane = tid & 63, wave = __builtin_amdgcn_readfirstlane(tid >> 6);
    const int gw = BID() * 8 + wave, NGW = GDIM() * 8;
    unsigned char* ws = WSP(); float* out = OUTP();
    const float* gkva = IN(8) + l * 256;
    const float* sp = IN(4) + (size_t)l * 32 * 15 * 512;
    const float* ssq_zkv = (const float*)(ws + O_SSQZ) + (size_t)(5 + l) * MT;
    const bf16_t* zkv = (const bf16_t*)(ws + O_ZKV); const bf16_t* pp = (const bf16_t*)(ws + O_PP); bf16_t* pooled = (bf16_t*)(ws + O_POOLED);
    float* ockv_p = out + OUT_CKVP + (size_t)l * MP * 256; float* ockv_s = out + OUT_CKVS + (size_t)l * MS * 256;
    for (int c = gw; c < MT / 16; c += NGW) {
        const int r0 = c * 16; const bool samp = r0 >= MP;
        {
            u32x2 z[16]; float sq[16];
#pragma unroll
            for (int i = 0; i < 16; ++i) { z[i] = *(const u32x2*)(zkv + (size_t)(r0 + i) * 256 + 4 * lane); sq[i] = ssq_zkv[r0 + i]; }
            const f32x4 g = *(const f32x4*)(gkva + 4 * lane);
            float* d0 = samp ? ockv_s + (size_t)(r0 - MP) * 256 : ockv_p + (size_t)r0 * 256;
#pragma unroll
            for (int i = 0; i < 16; ++i) {
                const float r = rsqrtf(sq[i] * (1.f / 256.f) + EPSF);
                f32x4 v = {bflo(z[i].x), bfhi(z[i].x), bflo(z[i].y), bfhi(z[i].y)}; v = v * r * g;
                *(f32x4*)(d0 + (size_t)i * 256 + 4 * lane) = v;
                if (samp) { u32x2 o; o.x = cvtpk(v[0], v[1]); o.y = cvtpk(v[2], v[3]); *(u32x2*)((bf16_t*)(ws + O_CKVN) + (size_t)(r0 - MP + i) * 256 + 4 * lane) = o; }
            }
        }
        {
            const int grp = lane >> 4, wsz = 2 << grp, ch = 8 * lane;
            u32x4 rw[31];
            const int t0 = r0 & 4095;
            if (!samp) {
#pragma unroll
                for (int k = 0; k < 15; ++k) rw[k] = (t0 >= 16) ? *(const u32x4*)(pp + (size_t)(r0 - 15 + k) * 512 + ch) : (u32x4){0u, 0u, 0u, 0u};
            } else {
                const float* q = sp + (size_t)((r0 - MP) >> 4) * 15 * 512 + ch;
#pragma unroll
                for (int k = 0; k < 15; ++k) rw[k] = pack8(*(const f32x4*)(q + (size_t)k * 512), *(const f32x4*)(q + (size_t)k * 512 + 4));
            }
#pragma unroll
            for (int k = 15; k < 31; ++k) rw[k] = *(const u32x4*)(pp + (size_t)(r0 + k - 15) * 512 + ch);
            f32x4 s0 = {0.f, 0.f, 0.f, 0.f}, s1 = s0;
#pragma unroll
            for (int j = 0; j < 16; ++j) if (j < wsz) { s0 += unpk_lo(rw[15 - j]); s1 += unpk_hi(rw[15 - j]); }
#pragma unroll
            for (int i = 0; i < 16; ++i) {
                if (i > 0) {
                    const u32x4 od = grp == 0 ? rw[13 + i] : grp == 1 ? rw[11 + i] : grp == 2 ? rw[7 + i] : rw[i - 1];
                    s0 += unpk_lo(rw[15 + i]) - unpk_lo(od); s1 += unpk_hi(rw[15 + i]) - unpk_hi(od);
                }
                const float ic = 1.f / (float)(samp ? wsz : min(wsz, t0 + i + 1));
                *(u32x4*)(pooled + (size_t)(r0 + i) * 512 + ch) = pack8(s0 * ic - unpk_lo(rw[15 + i]), s1 * ic - unpk_hi(rw[15 + i]));
            }
        }
    }
}

DEVI void attn_phase(int wv, LAS unsigned char* lds, int l) {
    const int G = GDIM(), bx = BID();
    const int vcu = (G % 8 == 0) ? (bx % 8) * (G / 8) + bx / 8 : bx;
    for (int pi = vcu; pi < 512; pi += G) {
        const int bh = pi >> 3, s = pi & 7, b = bh >> 3, h = bh & 7;
#pragma unroll 1
        for (int k = 0; k < 2; ++k) {
            unsigned char* ws = WSP();
            const float* ssq_qh = (const float*)(ws + O_SSQZ) + (size_t)(7 + 8 * l) * MT;
            const int qb = k == 0 ? s : 15 - s, q0 = qb * 256; const size_t tok0 = (size_t)b * 4096 + q0;
            attn_unit_p(wv, lds, (const bf16_t*)(ws + O_QP) + ((size_t)bh * 4096 + q0) * 96, ssq_qh + tok0 * 8 + h, (const bf16_t*)(ws + O_KP) + (size_t)bh * 4096 * 96,
                             (const bf16_t*)(ws + O_VTP) + (size_t)bh * 64 * 4096, 4096, 4 * qb + 4, 4 * qb, (bf16_t*)(ws + O_ATT) + tok0 * 512 + h * 64);
        }
    }
    for (int bh = vcu; bh < 256; bh += G) sample_attn_fused(wv, lds, l, bh);
}

static_assert((size_t)16 * MS * 1024 * 4 <= (size_t)MT * (384 + 256) * 2, "split-K partial buffer fits the dead q/kv-latent region");
DEVI void sample_fixup(int wv, int wxb) {
    const int tid = TID(), lane = tid & 63, wave = __builtin_amdgcn_readfirstlane(tid >> 6);
    const int gw = BID() * 8 + wave, NGW = GDIM() * 8;
    unsigned char* ws = WSP(); float* x = OUTP();
    const float* part = (const float*)(ws + O_ZQ);
    bf16_t* xb = (bf16_t*)(ws + O_XB); float* ssqA1 = (float*)(ws + O_SSQZ);
    for (int row = MP + gw; row < MT; row += NGW) {
        float s = 0.f;
#pragma unroll
        for (int j = 0; j < 4; ++j) {
            f32x4 v = *(const f32x4*)(x + (size_t)row * 1024 + 256 * j + 4 * lane);
#pragma unroll
            for (int k = 0; k < 16; ++k) v += *(const f32x4*)(part + ((size_t)k * MS + (row - MP)) * 1024 + 256 * j + 4 * lane);
            *(f32x4*)(x + (size_t)row * 1024 + 256 * j + 4 * lane) = v;
            s += ss4(v);
            if (wxb) { u32x2 o; o.x = cvtpk(v[0], v[1]); o.y = cvtpk(v[2], v[3]); *(u32x2*)(xb + (size_t)row * 1024 + 256 * j + 4 * lane) = o; }
        }
#pragma unroll
        for (int o = 1; o < 64; o <<= 1) s += __shfl_xor(s, o);
        if (wxb && lane == 0) ssqA1[row] = s;
    }
}

#define XB_TMO      128
#define XB_XCNT(j)  (256  + 64 * (j))
#define XB_XSUB(j)  (1280 + 64 * (j))
#define XB_XGEN(j)  (2304 + 64 * (j))
#define XB_TOP      3328
#define XB_TOPGEN   3392
#define XB_SPIN_CAP (1u << 18)
constexpr int LDS_MISC = 131072 + 320;
DEVI unsigned xb_ld(unsigned* p)              { return __hip_atomic_load(p, __ATOMIC_RELAXED, __HIP_MEMORY_SCOPE_AGENT); }
DEVI unsigned xb_add(unsigned* p, unsigned v) { return __hip_atomic_fetch_add(p, v, __ATOMIC_RELAXED, __HIP_MEMORY_SCOPE_AGENT); }
DEVI unsigned xb_xcc_id() { return (unsigned)__builtin_amdgcn_s_getreg((3 << 11) | 20) & 0xFu; }
#define XB_SPIN(cond, bar) do { unsigned _sp = 0; while (cond) { __builtin_amdgcn_s_sleep(1); \
    if ((++_sp & 255u) == 0u) { if (xb_ld(&(bar)[XB_TMO])) break; if (_sp > XB_SPIN_CAP) { atomicAdd(&(bar)[XB_TMO], 1u); break; } } } } while (0)
DEVI void xcd_barrier_post(int wv, LAS unsigned char* lds) {
    if (TID() == 0) {
        unsigned* bar = (unsigned*)(WSP() + O_CTL);
        volatile LAS unsigned* st = (volatile LAS unsigned*)(lds + LDS_MISC);
        st[0] = 0u; st[1] = 0u;
        (void)xb_add(&bar[XB_XCNT(xb_xcc_id())], 1u);
    }
    __syncthreads();
}
DEVI void xcd_barrier_complete(unsigned* bar, unsigned x, unsigned& nloc, unsigned& nx) {
    const unsigned G = (unsigned)gridDim.x;
    unsigned sum, cnt, mine, sp = 0u;
    for (;;) {
        sum = 0u; cnt = 0u; mine = 0u;
#pragma unroll
        for (unsigned j = 0; j < 16; ++j) { const unsigned c = xb_ld(&bar[XB_XCNT(j)]); sum += c; cnt += (c > 0u) ? 1u : 0u; mine = (j == x) ? c : mine; }
        if (sum == G) break;
        __builtin_amdgcn_s_sleep(1);
        if ((++sp & 255u) == 0u) { if (xb_ld(&bar[XB_TMO])) break; if (sp > XB_SPIN_CAP) { atomicAdd(&bar[XB_TMO], 1u); break; } }
    }
    nloc = mine > 0u ? mine : 1u; nx = cnt > 0u ? cnt : 1u;
}
DEVI void grid_bar(int wv, LAS unsigned char* lds) {
    asm volatile("s_waitcnt vmcnt(0)" ::: "memory");
    __syncthreads();
    if (TID() == 0) {
        unsigned* bar = (unsigned*)(WSP() + O_CTL);
        volatile LAS unsigned* st = (volatile LAS unsigned*)(lds + LDS_MISC);
        const unsigned x = xb_xcc_id();
        __builtin_amdgcn_s_waitcnt(0);
        unsigned nloc = st[0], nx = st[1];
        if (nloc == 0u) { xcd_barrier_complete(bar, x, nloc, nx); st[0] = nloc; st[1] = nx; }
        const unsigned old = xb_add(&bar[XB_XSUB(x)], 1u);
        const unsigned gen = old / nloc;
        if (old + 1u == (gen + 1u) * nloc) {
            __builtin_amdgcn_fence(__ATOMIC_RELEASE, "agent");
            asm volatile("s_waitcnt vmcnt(0)" ::: "memory");
            const unsigned og = xb_add(&bar[XB_TOP], 1u);
            const unsigned tg = og / nx;
            if (og + 1u == (tg + 1u) * nx) xb_add(&bar[XB_TOPGEN], 1u);
            else XB_SPIN(xb_ld(&bar[XB_TOPGEN]) == tg, bar);
            __builtin_amdgcn_fence(__ATOMIC_ACQUIRE, "agent");
            xb_add(&bar[XB_XGEN(x)], 1u);
            asm volatile("s_waitcnt vmcnt(0)" ::: "memory");
        } else {
            XB_SPIN(xb_ld(&bar[XB_XGEN(x)]) == gen, bar);
            __builtin_amdgcn_fence(__ATOMIC_ACQUIRE, "agent");
            asm volatile("s_waitcnt vmcnt(0)" ::: "memory");
        }
    }
    __syncthreads();
}

#define WL(l, o) ((const bf16_t*)(WSP() + O_W + (size_t)(l) * W_LAYER + (o)))
#define WSB(o) ((const bf16_t*)(WSP() + (o)))

__global__ void __launch_bounds__(512, 2) fwd_kernel(Args args_unused) {
    extern __shared__ __attribute__((aligned(16))) unsigned char lds_raw[];
    LAS unsigned char* lds = (LAS unsigned char*)lds_raw;
    cg::grid_group grid = cg::this_grid();
    const int wv = __builtin_amdgcn_readfirstlane((int)threadIdx.x >> 6);
    if (BID() == 0) { unsigned* bw = (unsigned*)(WSP() + O_CTL); for (int i = TID(); i < 4096; i += 512) bw[i] = 0u; }
    grid.sync();
    xcd_barrier_post(wv, lds);
    prologue(wv, lds);
    grid_bar(wv, lds);
#pragma unroll 1
    for (int l = 0; l < 2; ++l) {
        int off = 0;
        { EpiZ E{l}; run_gemm(wv, lds, WSB(O_XB), WL(l, W_IN), 1024, 1024, MT, NZ, 1024, off, E); }
        grid_bar(wv, lds);
        { EpiQ E{l}; run_gemm(wv, lds, WSB(O_ZQ), WL(l, W_UQ), 384, 384, MT, 768, 384, off, E); }
        { EpiK E{l, 0}; run_gemm(wv, lds, WSB(O_ZKV), WL(l, W_K), 256, 256, MP, 512, 256, off, E); }
        { EpiVT E{l, 0}; run_gemm(wv, lds, WL(l, W_V), WSB(O_ZKV), 256, 256, 512, MP, 256, off, E); }
        thin_rows(wv, l);
        grid_bar(wv, lds);
        attn_phase(wv, lds, l);
        { EpiGateB E{}; run_gemm(wv, lds, WSB(O_POOLED), WL(l, W_EFF), 512, 512, MT, 1024, 512, off, E); }
        grid_bar(wv, lds);
        { EpiGateA E{}; run_gemm(wv, lds, WSB(O_ATT), WL(l, W_A), 512, 512, MT, 1024, 512, off, E); }
        grid_bar(wv, lds);
        { EpiRes E{l == 0 ? 1 : 0, 1, 1 + l}; run_gemm(wv, lds, WSB(O_GB), WL(l, W_O), 1024, 1024, MT, 1024, 1024, off, E); }
        grid_bar(wv, lds);
        { EpiUp E{l}; run_gemm(wv, lds, WSB(O_XB), WL(l, W_UP), 1024, 1024, MT, DFF, 1024, off, E); }
        grid_bar(wv, lds);
        { EpiRes E{0, l == 0 ? 1 : 0, 0}; run_gemm(wv, lds, WSB(O_AH), WL(l, W_DN), DFF, DFF, MP, 1024, DFF, off, E); }
        { EpiPartS E{}; run_gemm(wv, lds, WSB(O_AH) + (size_t)MP * DFF, WL(l, W_DN), DFF, DFF, MS, 1024 * 16, 256, off, E, 4); }
        grid_bar(wv, lds);
        sample_fixup(wv, l == 0);
        if (l == 0) grid_bar(wv, lds);
    }
}

extern "C" void kernel_launch(void* const* d_in, const int* in_sizes, int n_in, void* d_out, int out_size, void* d_ws, size_t ws_size, hipStream_t stream) {
    static int grid = 0;
    if (grid == 0) {
        if (n_in != 21 || ws_size < O_END2) { fprintf(stderr, "kernel_launch: need 21 inputs and >= %zu bytes of workspace (got %d, %zu)\n", (size_t)O_END2, n_in, ws_size); grid = -1; return; }
        int dev = 0, cus = 0, per_cu = 0;
        (void)hipGetDevice(&dev); (void)hipDeviceGetAttribute(&cus, hipDeviceAttributeMultiprocessorCount, dev);
        (void)hipFuncSetAttribute((const void*)fwd_kernel, hipFuncAttributeMaxDynamicSharedMemorySize, LDS_BYTES);
        (void)hipOccupancyMaxActiveBlocksPerMultiprocessor(&per_cu, (const void*)fwd_kernel, 512, LDS_BYTES);
        if (per_cu < 1) fprintf(stderr, "kernel_launch: occupancy query says %d blocks per CU\n", per_cu);
        (void)hipGetLastError();
        grid = cus;
    }
    if (grid < 0) return;
    Args a{};
    for (int i = 0; i < 21; ++i) a.in[i] = (const float*)d_in[i];
    a.out = (float*)d_out; a.ws = (unsigned char*)d_ws;
    void* params[] = {&a};
    hipError_t e = hipLaunchCooperativeKernel((const void*)fwd_kernel, dim3(grid), dim3(512), params, LDS_BYTES, stream);
    if (e != hipSuccess) fprintf(stderr, "cooperative launch failed: %s (grid %d)\n", hipGetErrorString(e), grid);
}
```

```cpp
#include <hip/hip_runtime.h>
#include <hip/hip_cooperative_groups.h>
#include <cstdio>
#include <cstdint>
namespace cg = cooperative_groups;

#define DEVI __device__ __forceinline__
#define LAS __attribute__((address_space(3)))
__device__ __forceinline__ int opq_v(int x) { asm volatile("" : "+v"(x)); return x; }
__device__ __forceinline__ int opq_s(int x) { asm volatile("" : "+s"(x)); return x; }
__device__ __forceinline__ int tid_now(int wv) { int r; asm volatile("v_mbcnt_lo_u32_b32 %0, -1, 0\n\tv_mbcnt_hi_u32_b32 %0, -1, %0\n\tv_lshl_or_b32 %0, %1, 6, %0" : "=&v"(r) : "s"(wv)); return r; }
#define TID() tid_now(wv)
#define BID() opq_s((int)blockIdx.x)
#define GDIM() opq_s((int)gridDim.x)
typedef unsigned short bf16_t;
typedef short bf16x8 __attribute__((ext_vector_type(8)));
typedef float f32x4 __attribute__((ext_vector_type(4)));
typedef float f32x16 __attribute__((ext_vector_type(16)));
typedef unsigned u32x4 __attribute__((ext_vector_type(4)));
typedef unsigned u32x2 __attribute__((ext_vector_type(2)));
typedef float f32x2_t __attribute__((ext_vector_type(2)));
typedef __bf16 bf16x2_t __attribute__((ext_vector_type(2)));

constexpr int DM = 1024, MP = 32768, MS = 512, MT = MP + MS, MC = 131072, DFF = 4096;
constexpr int NZ = 3328;
constexpr int KSL = 4160;
constexpr float EPSF = 1e-6f;
constexpr float QSCALE = 0.10206207261596575f * 1.4426950408889634f;

DEVI unsigned cvtpk(float lo, float hi) { f32x2_t v = {lo, hi}; bf16x2_t b = __builtin_convertvector(v, bf16x2_t); return __builtin_bit_cast(unsigned, b); }
DEVI u32x4 pack8(const f32x4 a, const f32x4 b) { u32x4 w; w.x = cvtpk(a[0], a[1]); w.y = cvtpk(a[2], a[3]); w.z = cvtpk(b[0], b[1]); w.w = cvtpk(b[2], b[3]); return w; }
DEVI float bflo(unsigned w) { return __uint_as_float(w << 16); }
DEVI float bfhi(unsigned w) { return __uint_as_float(w & 0xffff0000u); }
DEVI f32x4 unpk_lo(const u32x4 w) { return (f32x4){bflo(w.x), bfhi(w.x), bflo(w.y), bfhi(w.y)}; }
DEVI f32x4 unpk_hi(const u32x4 w) { return (f32x4){bflo(w.z), bfhi(w.z), bflo(w.w), bfhi(w.w)}; }
DEVI float ss4(const f32x4 a) { return (a[0] * a[0] + a[1] * a[1]) + (a[2] * a[2] + a[3] * a[3]); }
DEVI float red_fq(float s) { s += __shfl_xor(s, 16); s += __shfl_xor(s, 32); return s; }
DEVI float max3a(float a, float b, float c) { float r; asm("v_max3_f32 %0, %1, %2, %3" : "=v"(r) : "v"(a), "v"(b), "v"(c)); return r; }
DEVI float max2a(float a, float b) { float r; asm("v_max_f32_e32 %0, %1, %2" : "=v"(r) : "v"(a), "v"(b)); return r; }
DEVI float sigm(float x) { return __builtin_amdgcn_rcpf(1.f + __builtin_amdgcn_exp2f(-1.4426950408889634f * x)); }

namespace pg8 {
constexpr int BM = 256, BK = 64, HALF = 128, HTB = HALF * BK * 2, STAGE_BYTES = 8 * HTB, NXCD = 8, WGM = 4;
__host__ __device__ __forceinline__ int lds_byte(int r, int c) { const int st = (r >> 4) * 2 + (c >> 5), rr = r & 15, cc = c & 31, ob = rr * 64 + cc * 2; return st * 1024 + (ob ^ (((ob >> 9) & 1) << 5)); }
__host__ __device__ __forceinline__ void stage_rc(int b, int& R, int& C) { const int st = b / 1024, sb = b % 1024, swz = sb ^ (((sb >> 9) & 1) << 5); R = (st >> 1) * 16 + swz / 64; C = (st & 1) * 32 + (swz % 64) / 2; }
__host__ __device__ __forceinline__ int perm32(int rho) { const int n = rho >> 4, i = rho & 15; return 8 * (i >> 2) + 4 * n + (i & 3); }

struct Unit { int pm, pn, ks; };
struct Gemm { const bf16_t* A; const bf16_t* Bt; int lda, ldb, K, nNr; };

struct StaticOrder {
    int nM, nN, nwg, G, c;
    __device__ void init(int M, int N, int G_, int c_) { nM = M / BM; nN = N / BM; nwg = nM * nN; G = G_; c = c_; }
    __device__ bool next(int i, Unit& u) const {
        const long L = (long)i * G + c; if (L >= nwg) return false;
        int wgid = (int)L; { const int q = nwg / NXCD, r = nwg % NXCD, xcd = wgid % NXCD, off = wgid / NXCD; wgid = (xcd < r ? xcd * (q + 1) : r * (q + 1) + (xcd - r) * q) + off; }
        const int nig = WGM * nN, gid = wgid / nig, fm = gid * WGM, gsz = (nM - fm) < WGM ? (nM - fm) : WGM;
        u.pm = fm + ((wgid % nig) % gsz); u.pn = (wgid % nig) / gsz; return true;
    }
};

template <class Epi, class Sched>
__device__ __forceinline__ void gemm_phase(int wv, LAS unsigned char* lds, const Gemm g, const Sched& S, const Epi& E) {
    const int tid = TID(), wid = __builtin_amdgcn_readfirstlane(tid >> 6), lane = tid & 63, wr = wid >> 2, wc = wid & 3, fr = lane & 15, fq = lane >> 4;
    const int K = g.K, nt = K / BK;
    unsigned voffA[2], voffB[2];
#pragma unroll
    for (int i = 0; i < 2; ++i) { int R, C; stage_rc(tid * 16 + i * 8192, R, C); const int Rb = Epi::PERM ? ((R & ~31) + perm32(R & 31)) : R;
        voffA[i] = (unsigned)(R * g.lda + C) * 2u; voffB[i] = (unsigned)(Rb * g.ldb + C) * 2u; }
    const size_t kstep = (size_t)(BK * 2);
    const unsigned hA = (unsigned)HALF * g.lda * 2u, hB = (unsigned)HALF * g.ldb * 2u;
    const unsigned tA = 2u * hA, tB = 2u * hB;
    const unsigned ldsw = (unsigned)wid * 1024u;
    const int aoff = lds_byte(wr * 64 + fr, fq * 8), boff = lds_byte(wc * 32 + fr, fq * 8);
#define PG8_SA(b, h) (((b) * 2 + (h)) * HTB)
#define PG8_SB(b, h) ((4 + (b) * 2 + (h)) * HTB)
#define PG8_STAGE(bufoff, gbase, voff) do { _Pragma("unroll") for (int _i = 0; _i < 2; ++_i) \
        __builtin_amdgcn_global_load_lds((const unsigned*)((const char*)(gbase) + (voff)[_i]), (LAS unsigned*)(lds + (bufoff) + ldsw + _i * 8192), 16, 0, 0); } while (0)
#define PG8_LDA(dst, b, h) do { _Pragma("unroll") for (int m = 0; m < 4; ++m) _Pragma("unroll") for (int k = 0; k < 2; ++k) dst[m][k] = *(const LAS bf16x8*)(lds + PG8_SA(b, h) + aoff + m * 2048 + k * 1024); } while (0)
#define PG8_LDB(dst, b, h) do { _Pragma("unroll") for (int n = 0; n < 2; ++n) _Pragma("unroll") for (int k = 0; k < 2; ++k) dst[n][k] = *(const LAS bf16x8*)(lds + PG8_SB(b, h) + boff + n * 2048 + k * 1024); } while (0)
#define PG8_MMA(ai, bj, At, Bt) do { __builtin_amdgcn_s_setprio(1); _Pragma("unroll") for (int m = 0; m < 4; ++m) _Pragma("unroll") for (int n = 0; n < 2; ++n) _Pragma("unroll") for (int k = 0; k < 2; ++k) \
        acc[ai][bj][m][n] = __builtin_amdgcn_mfma_f32_16x16x32_bf16(Bt[n][k], At[m][k], acc[ai][bj][m][n], 0, 0, 0); __builtin_amdgcn_s_setprio(0); } while (0)
#define PG8_WAIT_V(n) asm volatile("s_waitcnt vmcnt(" #n ")" ::: "memory")
#define PG8_WAIT_L(n) asm volatile("s_waitcnt lgkmcnt(" #n ")" ::: "memory")
#define PG8_BAR __builtin_amdgcn_s_barrier()
#define PG8_SCHED __builtin_amdgcn_sched_barrier(0)
    Unit cur, nxt; int ui = 0;
    if (!S.next(0, cur)) return;
    f32x4 acc[2][2][4][2];
#pragma unroll
    for (int a = 0; a < 2; ++a)
#pragma unroll
        for (int b = 0; b < 2; ++b)
#pragma unroll
            for (int m = 0; m < 4; ++m)
#pragma unroll
                for (int n = 0; n < 2; ++n) acc[a][b][m][n] = (f32x4){0.f, 0.f, 0.f, 0.f};
    bf16x8 At[4][2], B0[2][2], B1[2][2];
#define PG8_UA(u) ((const char*)g.A + (size_t)(u).pm * tA + (g.nNr ? (size_t)((u).pn / g.nNr) * K * 2 : (size_t)0))
#define PG8_UB(u) ((const char*)g.Bt + (size_t)(g.nNr ? (u).pn % g.nNr : (u).pn) * tB + (g.nNr ? (size_t)((u).pn / g.nNr) * K * 2 : (size_t)0))
    const char* cA = PG8_UA(cur); const char* cB = PG8_UB(cur);
    PG8_STAGE(PG8_SB(0, 0), cB, voffB); PG8_STAGE(PG8_SB(0, 1), cB + hB, voffB); PG8_STAGE(PG8_SA(0, 0), cA, voffA); PG8_STAGE(PG8_SA(0, 1), cA + hA, voffA);
    if (wr == 1) PG8_BAR;
    PG8_WAIT_V(2); PG8_BAR;
    PG8_STAGE(PG8_SB(1, 0), cB + kstep, voffB); PG8_STAGE(PG8_SA(1, 0), cA + kstep, voffA); PG8_STAGE(PG8_SB(1, 1), cB + hB + kstep, voffB);
    PG8_WAIT_V(6); PG8_BAR;
    for (;;) {
        const bool has_next = S.next(ui + 1, nxt);
        const char* nA = has_next ? PG8_UA(nxt) : cA; const char* nB = has_next ? PG8_UB(nxt) : cB;
        for (int t = 0; t < nt; t += 2) {
            const bool last = (t == nt - 2);
            const char* a1 = cA + (size_t)(t + 1) * kstep;
            const char* a2 = last ? nA : cA + (size_t)(t + 2) * kstep; const char* b2 = last ? nB : cB + (size_t)(t + 2) * kstep;
            const char* a3 = a2 + kstep; const char* b3 = b2 + kstep;
            PG8_LDB(B0, 0, 0); PG8_LDB(B1, 0, 1); PG8_SCHED; PG8_LDA(At, 0, 0); PG8_STAGE(PG8_SA(1, 1), a1 + hA, voffA);
            PG8_WAIT_V(8); PG8_WAIT_L(0); PG8_BAR; PG8_MMA(0, 0, At, B0); PG8_MMA(0, 1, At, B1); PG8_BAR; PG8_SCHED;
            PG8_LDA(At, 0, 1); PG8_STAGE(PG8_SB(0, 0), b2, voffB); PG8_STAGE(PG8_SB(0, 1), b2 + hB, voffB); PG8_STAGE(PG8_SA(0, 0), a2, voffA);
            PG8_WAIT_V(8); PG8_WAIT_L(0); PG8_BAR; PG8_MMA(1, 0, At, B0); PG8_MMA(1, 1, At, B1); PG8_BAR; PG8_SCHED;
            PG8_LDB(B0, 1, 0); PG8_LDB(B1, 1, 1); PG8_SCHED; PG8_LDA(At, 1, 0); PG8_STAGE(PG8_SA(0, 1), a2 + hA, voffA);
            PG8_WAIT_V(8); PG8_WAIT_L(0); PG8_BAR; PG8_MMA(0, 0, At, B0); PG8_MMA(0, 1, At, B1); PG8_BAR; PG8_SCHED;
            PG8_LDA(At, 1, 1); PG8_STAGE(PG8_SB(1, 0), b3, voffB); PG8_STAGE(PG8_SB(1, 1), b3 + hB, voffB); PG8_STAGE(PG8_SA(1, 0), a3, voffA);
            PG8_WAIT_V(8); PG8_WAIT_L(0); PG8_BAR; PG8_MMA(1, 0, At, B0); PG8_MMA(1, 1, At, B1); PG8_BAR; PG8_SCHED;
        }
        if (wr == 0) PG8_BAR;
        { const int t2 = TID(), w2 = __builtin_amdgcn_readfirstlane(t2 >> 6), l2 = t2 & 63; Unit eu = cur; eu.ks = 0; if (g.nNr) { eu.pn = cur.pn % g.nNr; eu.ks = cur.pn / g.nNr; } E(acc, eu, w2 >> 2, w2 & 3, l2 & 15, l2 >> 4); }
        if (!has_next) break;
#pragma unroll
        for (int a = 0; a < 2; ++a)
#pragma unroll
            for (int b = 0; b < 2; ++b)
#pragma unroll
                for (int m = 0; m < 4; ++m)
#pragma unroll
                    for (int n = 0; n < 2; ++n) acc[a][b][m][n] = (f32x4){0.f, 0.f, 0.f, 0.f};
        cur = nxt; cA = nA; cB = nB; ++ui;
        if (wr == 1) PG8_BAR;
    }
    PG8_WAIT_V(0);
    PG8_BAR;
#undef PG8_UA
#undef PG8_UB
#undef PG8_SA
#undef PG8_SB
#undef PG8_STAGE
#undef PG8_LDA
#undef PG8_LDB
#undef PG8_MMA
#undef PG8_WAIT_V
#undef PG8_WAIT_L
#undef PG8_BAR
#undef PG8_SCHED
}
}
using pg8::Unit;


constexpr size_t A256(size_t x) { return (x + 255) & ~(size_t)255; }
constexpr size_t O_CTL = 0;
constexpr size_t O_ROPE = 16384;
constexpr size_t O_SSQA0 = O_ROPE + A256((size_t)4112 * 16 * 8);
constexpr size_t O_SSQZ = O_SSQA0 + A256((size_t)MT * 4);
constexpr size_t SSQZ_FLOATS = (size_t)MT * (1 + 2 + 2 + 2 + 16);
constexpr size_t O_W = O_SSQZ + A256(SSQZ_FLOATS * 4);
constexpr size_t W_IN = 0, W_UQ = W_IN + (size_t)NZ * 1024 * 2, W_K = W_UQ + (size_t)768 * 384 * 2, W_V = W_K + 512 * 256 * 2, W_KC = W_V + 512 * 256 * 2, W_VC = W_KC + 512 * 256 * 2,
                 W_A = W_VC + 512 * 256 * 2, W_EFF = W_A + 1024 * 512 * 2, W_O = W_EFF + 1024 * 512 * 2, W_UP = W_O + 1024 * 1024 * 2, W_DN = W_UP + (size_t)4096 * 1024 * 2, W_LAYER = W_DN + (size_t)4096 * 1024 * 2;
constexpr size_t O_CKVB = O_W + 2 * W_LAYER;
constexpr size_t O_XB = O_CKVB + (size_t)2 * MC * 256 * 2;
constexpr size_t O_ZQ = O_XB + (size_t)MT * 1024 * 2;
constexpr size_t O_ZKV = O_ZQ + (size_t)MT * 384 * 2;
constexpr size_t O_PP = O_ZKV + (size_t)MT * 256 * 2;
constexpr size_t O_GA = O_PP + (size_t)MT * 512 * 2;
constexpr size_t O_GB = O_GA + (size_t)MT * 1024 * 2;
constexpr size_t O_POOLED = O_GB + (size_t)MT * 1024 * 2;
constexpr size_t O_QP = O_POOLED + (size_t)MT * 512 * 2;
constexpr size_t O_QS = O_QP + (size_t)MP * 768 * 2;
constexpr size_t O_KP = O_QS + (size_t)MS * 768 * 2;
constexpr size_t O_VTP = O_KP + (size_t)MP * 768 * 2;
constexpr size_t O_ATT = O_VTP + (size_t)MP * 512 * 2;
constexpr size_t O_KS = O_ATT + (size_t)MT * 512 * 2;
constexpr size_t O_VTS = O_KS + (size_t)256 * KSL * 96 * 2;
constexpr size_t O_END = O_VTS + (size_t)256 * 64 * KSL * 2;
constexpr size_t O_CKVN = O_END;
constexpr size_t O_END2 = O_CKVN + (size_t)MS * 256 * 2;
constexpr size_t O_AH = O_KS;
static_assert((size_t)MT * DFF * 2 <= O_END - O_KS, "FFN hidden overlay");

constexpr size_t OUT_Y = 0, OUT_CKVP = (size_t)MT * 1024, OUT_KRP = OUT_CKVP + (size_t)2 * MP * 256, OUT_PLP = OUT_KRP + (size_t)2 * MP * 32, OUT_CKVS = OUT_PLP + (size_t)2 * 8 * 15 * 512,
                 OUT_KRS = OUT_CKVS + (size_t)2 * MS * 256, OUT_PLS = OUT_KRS + (size_t)2 * MS * 32;

constexpr int LDS_BYTES = 147456;

typedef const __attribute__((address_space(4))) unsigned char* karg_t;
DEVI karg_t kargs() { karg_t p = (karg_t)__builtin_amdgcn_kernarg_segment_ptr(); asm volatile("" : "+s"(p)); return p; }
DEVI const float* IN(int i) { return *(const float* const __attribute__((address_space(4)))*)(kargs() + 8 * i); }
DEVI float* OUTP() { return *(float* const __attribute__((address_space(4)))*)(kargs() + 8 * 21); }
DEVI unsigned char* WSP() { return *(unsigned char* const __attribute__((address_space(4)))*)(kargs() + 8 * 22); }
#define FENCE() asm volatile("" ::: "memory")

DEVI void rope_cs(int pos, int half, int j, float& c, float& s) {
    constexpr float KREV[8] = {0.15915494309189535f, 0.08949940160889101f, 0.050329212104487035f, 0.0283021958306234f, 0.015915494309189534f, 0.008949940160889102f, 0.005032921210448704f, 0.00283021958306234f};
    const float rev = __builtin_amdgcn_fractf((float)pos * (KREV[j] * (half ? 0.01f : 1.f)));
    c = __builtin_amdgcn_cosf(rev); s = __builtin_amdgcn_sinf(rev);
}

typedef const f32x4 (&AccRef)[2][2][4][2];
#define ROWLOOP _Pragma("unroll") for (int ai = 0; ai < 2; ++ai) _Pragma("unroll") for (int m = 0; m < 4; ++m)
#define ROWOF(u) ((u).pm * 256 + ai * 128 + wr * 64 + m * 16 + fr)

struct EpiZ {
    static constexpr bool PERM = true;
    int l;
    DEVI void operator()(AccRef acc, const Unit& u, int wr, int wc, int fr, int fq) const {
        unsigned char* ws = WSP(); float* out = OUTP();
        const float* ssqx = (const float*)(ws + (l == 0 ? O_SSQA0 : O_SSQZ));
        float* ssqz = (float*)(ws + O_SSQZ);
        const int pn = u.pn, cw = wc * 32 + 8 * fq;
        float rq[2][4];
        ROWLOOP rq[ai][m] = ssqx[ROWOF(u)];
        ROWLOOP {
            const int row = ROWOF(u);
            const float r = rsqrtf(rq[ai][m] * (1.f / 1024.f) + EPSF);
            const f32x4 v00 = acc[ai][0][m][0] * r, v01 = acc[ai][0][m][1] * r, v10 = acc[ai][1][m][0] * r, v11 = acc[ai][1][m][1] * r;
            if (pn == 0) {
                bf16_t* zq = (bf16_t*)(ws + O_ZQ) + (size_t)row * 384 + cw;
                *(u32x4*)zq = pack8(v00, v01); *(u32x4*)(zq + 128) = pack8(v10, v11);
                const float s = red_fq((ss4(v00) + ss4(v01)) + (ss4(v10) + ss4(v11)));
                if (fq == 0) unsafeAtomicAdd(ssqz + (size_t)(3 + l) * MT + row, s);
            } else if (pn == 1) {
                bf16_t* zq = (bf16_t*)(ws + O_ZQ) + (size_t)row * 384 + 256 + cw;
                *(u32x4*)zq = pack8(v00, v01);
                const float s = red_fq(ss4(v00) + ss4(v01));
                if (fq == 0) unsafeAtomicAdd(ssqz + (size_t)(3 + l) * MT + row, s);
                if (wc == 0) {
                    const int pos = row < MP ? (row & 4095) : 4096 + ((row - MP) & 15);
                    float* dst = row < MP ? out + OUT_KRP + ((size_t)l * MP + row) * 32 : out + OUT_KRS + ((size_t)l * MS + (row - MP)) * 32;
                    const float sg = fq < 2 ? -1.f : 1.f;
                    f32x4 o0, o1;
#pragma unroll
                    for (int j = 0; j < 4; ++j) { float cc, sn; rope_cs(pos, fq & 1, j, cc, sn); const float ot = __shfl_xor(v10[j], 32); o0[j] = v10[j] * cc + sg * ot * sn; }
#pragma unroll
                    for (int j = 0; j < 4; ++j) { float cc, sn; rope_cs(pos, fq & 1, 4 + j, cc, sn); const float ot = __shfl_xor(v11[j], 32); o1[j] = v11[j] * cc + sg * ot * sn; }
                    *(f32x4*)(dst + 8 * fq) = o0; *(f32x4*)(dst + 8 * fq + 4) = o1;
                }
            } else if (pn == 2) {
                bf16_t* zkv = (bf16_t*)(ws + O_ZKV) + (size_t)row * 256 + cw;
                *(u32x4*)zkv = pack8(v00, v01); *(u32x4*)(zkv + 128) = pack8(v10, v11);
                const float s = red_fq((ss4(v00) + ss4(v01)) + (ss4(v10) + ss4(v11)));
                if (fq == 0) unsafeAtomicAdd(ssqz + (size_t)(5 + l) * MT + row, s);
            } else if (pn <= 4) {
                const int col = (pn - 3) * 256 + cw;
                bf16_t* pp = (bf16_t*)(ws + O_PP) + (size_t)row * 512 + col;
                *(u32x4*)pp = pack8(v00, v01); *(u32x4*)(pp + 128) = pack8(v10, v11);
                float* pd = nullptr;
                if (row < MP) { const int t = row & 4095; if (t >= 4081) pd = out + OUT_PLP + ((size_t)l * 8 * 15 + (row >> 12) * 15 + (t - 4081)) * 512; }
                else { const int rr = row - MP, i = rr & 15; if (i >= 1) pd = out + OUT_PLS + ((size_t)l * 32 * 15 + (rr >> 4) * 15 + (i - 1)) * 512; }
                if (pd) { *(f32x4*)(pd + col) = v00; *(f32x4*)(pd + col + 4) = v01; *(f32x4*)(pd + col + 128) = v10; *(f32x4*)(pd + col + 132) = v11; }
            } else {
                bf16_t* g = (bf16_t*)(ws + (pn <= 8 ? O_GA : O_GB)) + (size_t)row * 1024 + ((pn - 5) & 3) * 256 + cw;
                f32x4 a, b, c, d;
#pragma unroll
                for (int j = 0; j < 4; ++j) { a[j] = sigm(v00[j]); b[j] = sigm(v01[j]); c[j] = sigm(v10[j]); d[j] = sigm(v11[j]); }
                *(u32x4*)g = pack8(a, b); *(u32x4*)(g + 128) = pack8(c, d);
            }
            FENCE();
        }
    }
};

DEVI bf16_t* q_ptr(unsigned char* ws, int row, int hd) {
    if (row < MP) return (bf16_t*)(ws + O_QP) + ((size_t)((row >> 12) * 8 + hd) * 4096 + (row & 4095)) * 96;
    const int rr = row - MP; return (bf16_t*)(ws + O_QS) + ((size_t)((rr >> 4) * 8 + hd) * 16 + (rr & 15)) * 96;
}
struct EpiQ {
    static constexpr bool PERM = true;
    int l;
    DEVI void operator()(AccRef acc, const Unit& u, int wr, int wc, int fr, int fq) const {
        unsigned char* ws = WSP(); const float* gq = IN(11) + l * 96;
        const float* ssq_zq = (const float*)(ws + O_SSQZ) + (size_t)(3 + l) * MT;
        float* ssq_qh = (float*)(ws + O_SSQZ) + (size_t)(7 + 8 * l) * MT;
        const int pn = u.pn;
        const f32x4 gA = *(const f32x4*)(gq + (pn < 2 ? 0 : 64) + 8 * fq), gB = *(const f32x4*)(gq + (pn < 2 ? 4 : 68) + 8 * fq), gC = *(const f32x4*)(gq + 32 + 8 * fq), gD = *(const f32x4*)(gq + 36 + 8 * fq);
        float rq[2][4];
        ROWLOOP rq[ai][m] = ssq_zq[ROWOF(u)];
        ROWLOOP {
            const int row = ROWOF(u);
            const float r = rsqrtf(rq[ai][m] * (1.f / 384.f) + EPSF);
            const f32x4 v00 = acc[ai][0][m][0] * r, v01 = acc[ai][0][m][1] * r, v10 = acc[ai][1][m][0] * r, v11 = acc[ai][1][m][1] * r;
            if (pn < 2) {
                const int hd = 4 * pn + wc;
                const float s = red_fq((ss4(v00) + ss4(v01)) + (ss4(v10) + ss4(v11)));
                if (fq == 0) unsafeAtomicAdd(ssq_qh + (size_t)row * 8 + hd, s);
                bf16_t* qd = q_ptr(ws, row, hd);
                *(u32x4*)(qd + 8 * fq) = pack8(v00 * gA, v01 * gB); *(u32x4*)(qd + 32 + 8 * fq) = pack8(v10 * gC, v11 * gD);
            } else {
                const int pos = row < MP ? (row & 4095) : 4096 + ((row - MP) & 15);
                const float sg = fq < 2 ? -1.f : 1.f;
                float cs[8], sn[8];
#pragma unroll
                for (int j = 0; j < 8; ++j) rope_cs(pos, fq & 1, j, cs[j], sn[j]);
                const f32x4 g0 = gA, g1 = gB;
#pragma unroll
                for (int bj = 0; bj < 2; ++bj) {
                    const f32x4 x0 = bj ? v10 : v00, x1 = bj ? v11 : v01;
                    const int hd = 4 * bj + wc;
                    const float s = red_fq(ss4(x0) + ss4(x1));
                    if (fq == 0) unsafeAtomicAdd(ssq_qh + (size_t)row * 8 + hd, s);
                    f32x4 o0, o1;
#pragma unroll
                    for (int j = 0; j < 4; ++j) { const float ot = __shfl_xor(x0[j], 32); o0[j] = x0[j] * cs[j] + sg * ot * sn[j]; }
#pragma unroll
                    for (int j = 0; j < 4; ++j) { const float ot = __shfl_xor(x1[j], 32); o1[j] = x1[j] * cs[4 + j] + sg * ot * sn[4 + j]; }
                    *(u32x4*)(q_ptr(ws, row, hd) + 64 + 8 * fq) = pack8(o0 * g0, o1 * g1);
                }
            }
            FENCE();
        }
    }
};

struct EpiK {
    static constexpr bool PERM = true;
    int l, cache;
    DEVI void operator()(AccRef acc, const Unit& u, int wr, int wc, int fr, int fq) const {
        unsigned char* ws = WSP(); const float* gk = IN(12) + l * 96;
        const float* krc = cache ? IN(3) + (size_t)l * MC * 32 : OUTP();
        const float* ssq_zkv = (const float*)(ws + O_SSQZ) + (size_t)(5 + l) * MT;
        const int hd = 4 * u.pn + wc;
        const bool samp = !cache && (u.pm * 256 >= MP);
        bf16_t* kbase = (bf16_t*)(ws + ((cache || samp) ? O_KS : O_KP));
#pragma unroll
        for (int ai = 0; ai < 2; ++ai) {
            f32x4 k0[4], k1[4]; float rr[4]; unsigned ko[4];
#pragma unroll
            for (int m = 0; m < 4; ++m) {
                const int row = ROWOF(u);
                const float* krp;
                if (cache) { krp = krc + (size_t)row * 32; ko[m] = ((unsigned)((row >> 12) * 8 + hd) * KSL + (row & 4095)) * 96u; rr[m] = 1.f; }
                else {
                    rr[m] = ssq_zkv[row];
                    if (!samp) { krp = krc + OUT_KRP + ((size_t)l * MP + row) * 32; ko[m] = ((unsigned)((row >> 12) * 8 + hd) * 4096u + (row & 4095)) * 96u; }
                    else { const int rw = row - MP; krp = krc + OUT_KRS + ((size_t)l * MS + rw) * 32; ko[m] = ((unsigned)((rw >> 4) * 8 + hd) * KSL + 4096u + (rw & 15)) * 96u; }
                }
                k0[m] = *(const f32x4*)(krp + 8 * fq); k1[m] = *(const f32x4*)(krp + 8 * fq + 4);
            }
            const f32x4 g0 = *(const f32x4*)(gk + 8 * fq), g1 = *(const f32x4*)(gk + 8 * fq + 4), g2 = *(const f32x4*)(gk + 32 + 8 * fq), g3 = *(const f32x4*)(gk + 36 + 8 * fq),
                        g4 = *(const f32x4*)(gk + 64 + 8 * fq), g5 = *(const f32x4*)(gk + 68 + 8 * fq);
#pragma unroll
            for (int m = 0; m < 4; ++m) {
                const float r = cache ? 1.f : rsqrtf(rr[m] * (1.f / 256.f) + EPSF);
                const f32x4 v00 = acc[ai][0][m][0] * r, v01 = acc[ai][0][m][1] * r, v10 = acc[ai][1][m][0] * r, v11 = acc[ai][1][m][1] * r;
                const float s = red_fq(((ss4(v00) + ss4(v01)) + (ss4(v10) + ss4(v11))) + (ss4(k0[m]) + ss4(k1[m])));
                const float sc = rsqrtf(s * (1.f / 96.f) + EPSF);
                bf16_t* kd = kbase + ko[m];
                *(u32x4*)(kd + 8 * fq) = pack8(v00 * (g0 * sc), v01 * (g1 * sc));
                *(u32x4*)(kd + 32 + 8 * fq) = pack8(v10 * (g2 * sc), v11 * (g3 * sc));
                *(u32x4*)(kd + 64 + 8 * fq) = pack8(k0[m] * (g4 * sc), k1[m] * (g5 * sc));
            }
            FENCE();
        }
    }
};

struct EpiVT {
    static constexpr bool PERM = true;
    int l, cache;
    DEVI void operator()(AccRef acc, const Unit& u, int wr, int wc, int fr, int fq) const {
        unsigned char* ws = WSP();
        const float* ssq_zkv = (const float*)(ws + O_SSQZ) + (size_t)(5 + l) * MT;
        const bool samp = !cache && (u.pn * 256 >= MP);
        bf16_t* vbase = (bf16_t*)(ws + ((cache || samp) ? O_VTS : O_VTP));
        const unsigned ld = (cache || samp) ? KSL : 4096;
#pragma unroll
        for (int bj = 0; bj < 2; ++bj) {
            const int tok0 = u.pn * 256 + bj * 128 + wc * 32 + 8 * fq;
            f32x4 r0 = {1.f, 1.f, 1.f, 1.f}, r1 = r0;
            unsigned pos;
            if (!cache) {
                const f32x4 s0 = *(const f32x4*)(ssq_zkv + tok0), s1 = *(const f32x4*)(ssq_zkv + tok0 + 4);
#pragma unroll
                for (int j = 0; j < 4; ++j) { r0[j] = rsqrtf(s0[j] * (1.f / 256.f) + EPSF); r1[j] = rsqrtf(s1[j] * (1.f / 256.f) + EPSF); }
            }
            if (samp) { const int rr = tok0 - MP; pos = (unsigned)(rr >> 4) * 512u * ld + 4096u + ((rr & 8) ? 4u : 0u); }
            else pos = (unsigned)(tok0 >> 12) * 512u * ld + (unsigned)((tok0 & 4095) & ~15) + ((tok0 & 8) ? 4u : 0u);
            ROWLOOP {
                const int c = ROWOF(u);
                const f32x4 a = acc[ai][bj][m][0] * r0, b = acc[ai][bj][m][1] * r1;
                bf16_t* d = vbase + (pos + (unsigned)c * ld);
                u32x2 w0, w1; w0.x = cvtpk(a[0], a[1]); w0.y = cvtpk(a[2], a[3]); w1.x = cvtpk(b[0], b[1]); w1.y = cvtpk(b[2], b[3]);
                *(u32x2*)d = w0; *(u32x2*)(d + 8) = w1;
                FENCE();
            }
        }
    }
};

struct EpiGateB {
    static constexpr bool PERM = true;
    DEVI void operator()(AccRef acc, const Unit& u, int wr, int wc, int fr, int fq) const {
        bf16_t* gb = (bf16_t*)(WSP() + O_GB);
#pragma unroll
        for (int ai = 0; ai < 2; ++ai) {
            u32x4 w[4][2];
#pragma unroll
            for (int m = 0; m < 4; ++m)
#pragma unroll
                for (int bj = 0; bj < 2; ++bj) w[m][bj] = *(const u32x4*)(gb + (unsigned)ROWOF(u) * 1024u + u.pn * 256 + bj * 128 + wc * 32 + 8 * fq);
#pragma unroll
            for (int m = 0; m < 4; ++m)
#pragma unroll
                for (int bj = 0; bj < 2; ++bj)
                    *(u32x4*)(gb + (unsigned)ROWOF(u) * 1024u + u.pn * 256 + bj * 128 + wc * 32 + 8 * fq) = pack8(acc[ai][bj][m][0] * unpk_lo(w[m][bj]), acc[ai][bj][m][1] * unpk_hi(w[m][bj]));
            FENCE();
        }
    }
};
struct EpiGateA {
    static constexpr bool PERM = true;
    DEVI void operator()(AccRef acc, const Unit& u, int wr, int wc, int fr, int fq) const {
        unsigned char* ws = WSP();
        const bf16_t* ga = (const bf16_t*)(ws + O_GA); bf16_t* mb = (bf16_t*)(ws + O_GB);
#pragma unroll
        for (int ai = 0; ai < 2; ++ai) {
            u32x4 g[4][2], w[4][2];
#pragma unroll
            for (int m = 0; m < 4; ++m)
#pragma unroll
                for (int bj = 0; bj < 2; ++bj) { const unsigned off = (unsigned)ROWOF(u) * 1024u + u.pn * 256 + bj * 128 + wc * 32 + 8 * fq; g[m][bj] = *(const u32x4*)(ga + off); w[m][bj] = *(const u32x4*)(mb + off); }
#pragma unroll
            for (int m = 0; m < 4; ++m)
#pragma unroll
                for (int bj = 0; bj < 2; ++bj) { const unsigned off = (unsigned)ROWOF(u) * 1024u + u.pn * 256 + bj * 128 + wc * 32 + 8 * fq;
                    *(u32x4*)(mb + off) = pack8(acc[ai][bj][m][0] * unpk_lo(g[m][bj]) + unpk_lo(w[m][bj]), acc[ai][bj][m][1] * unpk_hi(g[m][bj]) + unpk_hi(w[m][bj])); }
            FENCE();
        }
    }
};
struct EpiRes {
    static constexpr bool PERM = true;
    int from_in, wxb, ssq_slot;
    DEVI void operator()(AccRef acc, const Unit& u, int wr, int wc, int fr, int fq) const {
        unsigned char* ws = WSP(); float* out = OUTP();
        const bool samp = u.pm * 256 >= MP;
        const float* base = from_in ? (samp ? IN(1) - (size_t)MP * 1024 : IN(0)) : out;
        bf16_t* xb = (bf16_t*)(ws + O_XB); float* ssq = (float*)(ws + O_SSQZ) + (size_t)ssq_slot * MT;
#pragma unroll
        for (int ai = 0; ai < 2; ++ai) {
            f32x4 b0[4][2], b1[4][2];
#pragma unroll
            for (int m = 0; m < 4; ++m)
#pragma unroll
                for (int bj = 0; bj < 2; ++bj) { const float* bp = base + (unsigned)ROWOF(u) * 1024u + u.pn * 256 + bj * 128 + wc * 32 + 8 * fq; b0[m][bj] = *(const f32x4*)bp; b1[m][bj] = *(const f32x4*)(bp + 4); }
#pragma unroll
            for (int m = 0; m < 4; ++m) {
                const int row = ROWOF(u);
                float s = 0.f;
#pragma unroll
                for (int bj = 0; bj < 2; ++bj) {
                    const unsigned off = (unsigned)row * 1024u + u.pn * 256 + bj * 128 + wc * 32 + 8 * fq;
                    const f32x4 o0 = b0[m][bj] + acc[ai][bj][m][0], o1 = b1[m][bj] + acc[ai][bj][m][1];
                    *(f32x4*)(out + off) = o0; *(f32x4*)(out + off + 4) = o1;
                    if (wxb) { *(u32x4*)(xb + off) = pack8(o0, o1); s += ss4(o0) + ss4(o1); }
                }
                if (wxb) { s = red_fq(s); if (fq == 0) unsafeAtomicAdd(ssq + row, s); }
            }
            FENCE();
        }
    }
};
struct EpiPartS {
    static constexpr bool PERM = true;
    DEVI void operator()(AccRef acc, const Unit& u, int wr, int wc, int fr, int fq) const {
        float* part = (float*)(WSP() + O_ZQ) + (size_t)u.ks * MS * 1024;
        ROWLOOP {
            const int row = ROWOF(u);
#pragma unroll
            for (int bj = 0; bj < 2; ++bj) {
                float* o = part + (unsigned)row * 1024u + u.pn * 256 + bj * 128 + wc * 32 + 8 * fq;
                *(f32x4*)o = acc[ai][bj][m][0]; *(f32x4*)(o + 4) = acc[ai][bj][m][1];
            }
        }
    }
};
struct EpiUp {
    static constexpr bool PERM = true;
    int l;
    DEVI void operator()(AccRef acc, const Unit& u, int wr, int wc, int fr, int fq) const {
        unsigned char* ws = WSP();
        const float* ssq = (const float*)(ws + O_SSQZ) + (size_t)(1 + l) * MT; bf16_t* ah = (bf16_t*)(ws + O_AH);
        ROWLOOP {
            const int row = ROWOF(u);
            const float r = rsqrtf(ssq[row] * (1.f / 1024.f) + EPSF);
#pragma unroll
            for (int bj = 0; bj < 2; ++bj) {
                f32x4 a = acc[ai][bj][m][0] * r, b = acc[ai][bj][m][1] * r;
#pragma unroll
                for (int j = 0; j < 4; ++j) { const float x = fmaxf(a[j], 0.f), y = fmaxf(b[j], 0.f); a[j] = x * x; b[j] = y * y; }
                *(u32x4*)(ah + (size_t)row * DFF + u.pn * 256 + bj * 128 + wc * 32 + 8 * fq) = pack8(a, b);
            }
        }
    }
};

constexpr int AT_KB = 64 * 208, AT_VB = 64 * 144, AT_TB = AT_KB + AT_VB;
#define MFMA32(a, b, c) __builtin_amdgcn_mfma_f32_32x32x16_bf16((a), (b), (c), 0, 0, 0)
template <bool SAMPLE>
DEVI void attn_unit(int wv, LAS unsigned char* lds, const bf16_t* Qb, const float* ssq_q, const bf16_t* Kb, const bf16_t* VTb, int ldv, int NT, int vis0, bf16_t* Ob) {
    const int tid = TID(), lane = tid & 63, r32 = lane & 31, hi = lane >> 5, w = __builtin_amdgcn_readfirstlane(tid >> 6);
    const int rloc = SAMPLE ? (r32 & 15) : 32 * w + r32;
    const int lastvis = SAMPLE ? NT : vis0 + (w >> 1);
    bf16x8 qr[6];
    {
        const float sq = rsqrtf(ssq_q[(size_t)rloc * 8] * (1.f / 96.f) + EPSF) * QSCALE;
#pragma unroll
        for (int d0 = 0; d0 < 6; ++d0) {
            const u32x4 wv = *(const u32x4*)(Qb + (size_t)rloc * 96 + 16 * d0 + 8 * hi);
            const u32x4 pk = pack8(unpk_lo(wv) * sq, unpk_hi(wv) * sq);
            qr[d0] = __builtin_bit_cast(bf16x8, pk);
        }
    }
    const int kp0 = tid, kp1 = 512 + tid;
    const int koff0 = (kp0 / 12) * 208 + (kp0 % 12) * 16, koff1 = (kp1 / 12) * 208 + (kp1 % 12) * 16;
    const int vd = tid >> 3, vc = tid & 7, voffl = AT_KB + vd * 144 + vc * 16;
    const bf16_t* vsrc = VTb + (size_t)vd * ldv + vc * 8;
    u32x4 kr0, kr1 = {0u, 0u, 0u, 0u}, vr;
#define AT_LOAD(t) do { kr0 = *(const u32x4*)(Kb + (size_t)(t) * 6144 + kp0 * 8); if (tid < 256) kr1 = *(const u32x4*)(Kb + (size_t)(t) * 6144 + kp1 * 8); vr = *(const u32x4*)(vsrc + (size_t)(t) * 64); } while (0)
#define AT_STORE(buf) do { LAS unsigned char* b_ = lds + (buf) * AT_TB; *(LAS u32x4*)(b_ + koff0) = kr0; if (tid < 256) *(LAS u32x4*)(b_ + koff1) = kr1; *(LAS u32x4*)(b_ + voffl) = vr; } while (0)
    float m_run = -INFINITY, l_run = 0.f;
    f32x16 o0, o1;
#pragma unroll
    for (int r = 0; r < 16; ++r) { o0[r] = 0.f; o1[r] = 0.f; }
    AT_LOAD(0); AT_STORE(0);
    __syncthreads();
    for (int t = 0; t < NT; ++t) {
        if (t + 1 < NT) AT_LOAD(t + 1);
        const bool active = SAMPLE ? ((t & 7) == w) : (t <= lastvis);
        if (active) {
            const LAS unsigned char* kb = lds + (t & 1) * AT_TB + r32 * 208 + hi * 16;
            const LAS unsigned char* vb = lds + (t & 1) * AT_TB + AT_KB + r32 * 144 + hi * 16;
            f32x16 p0, p1;
#pragma unroll
            for (int r = 0; r < 16; ++r) { p0[r] = 0.f; p1[r] = 0.f; }
#pragma unroll
            for (int d0 = 0; d0 < 6; ++d0) {
                const bf16x8 a0 = *(const LAS bf16x8*)(kb + d0 * 32), a1 = *(const LAS bf16x8*)(kb + 32 * 208 + d0 * 32);
                p0 = MFMA32(a0, qr[d0], p0); p1 = MFMA32(a1, qr[d0], p1);
            }
            if (SAMPLE && t == NT - 1) {
#pragma unroll
                for (int r = 0; r < 16; ++r) { if (r >= 8) p0[r] = -INFINITY; p1[r] = -INFINITY; }
            }
            float mx = fmaxf(p0[0], p1[0]);
#pragma unroll
            for (int r = 1; r < 16; ++r) mx = fmaxf(mx, fmaxf(p0[r], p1[r]));
            mx = fmaxf(mx, __shfl_xor(mx, 32));
            const float mn = fmaxf(m_run, mx), alpha = __builtin_amdgcn_exp2f(m_run - mn);
            m_run = mn;
            float rs = 0.f;
#pragma unroll
            for (int r = 0; r < 16; ++r) { p0[r] = __builtin_amdgcn_exp2f(p0[r] - mn); p1[r] = __builtin_amdgcn_exp2f(p1[r] - mn); rs += p0[r] + p1[r]; }
            l_run = l_run * alpha + rs;
#pragma unroll
            for (int r = 0; r < 16; ++r) { o0[r] *= alpha; o1[r] *= alpha; }
            u32x4 pw[4];
#pragma unroll
            for (int s = 0; s < 2; ++s) {
                pw[s] = (u32x4){cvtpk(p0[8 * s], p0[8 * s + 1]), cvtpk(p0[8 * s + 2], p0[8 * s + 3]), cvtpk(p0[8 * s + 4], p0[8 * s + 5]), cvtpk(p0[8 * s + 6], p0[8 * s + 7])};
                pw[2 + s] = (u32x4){cvtpk(p1[8 * s], p1[8 * s + 1]), cvtpk(p1[8 * s + 2], p1[8 * s + 3]), cvtpk(p1[8 * s + 4], p1[8 * s + 5]), cvtpk(p1[8 * s + 6], p1[8 * s + 7])};
            }
#pragma unroll
            for (int ks = 0; ks < 4; ++ks) {
                const bf16x8 va = *(const LAS bf16x8*)(vb + ks * 32), vb2 = *(const LAS bf16x8*)(vb + 32 * 144 + ks * 32);
                const bf16x8 pb = __builtin_bit_cast(bf16x8, pw[ks]);
                o0 = MFMA32(va, pb, o0); o1 = MFMA32(vb2, pb, o1);
            }
        }
        if (t + 1 < NT) AT_STORE((t + 1) & 1);
        __syncthreads();
    }
#undef AT_LOAD
#undef AT_STORE
    const float lt = l_run + __shfl_xor(l_run, 32);
    if (!SAMPLE) {
        const float inv = 1.f / lt;
        bf16_t* od = Ob + (size_t)rloc * 512 + 4 * hi;
#pragma unroll
        for (int rg = 0; rg < 4; ++rg) {
            u32x2 a, b; a.x = cvtpk(o0[4 * rg] * inv, o0[4 * rg + 1] * inv); a.y = cvtpk(o0[4 * rg + 2] * inv, o0[4 * rg + 3] * inv);
            b.x = cvtpk(o1[4 * rg] * inv, o1[4 * rg + 1] * inv); b.y = cvtpk(o1[4 * rg + 2] * inv, o1[4 * rg + 3] * inv);
            *(u32x2*)(od + 8 * rg) = a; *(u32x2*)(od + 32 + 8 * rg) = b;
        }
    } else {
        LAS float* cm = (LAS float*)lds; LAS float* cl = cm + 128; LAS float* co = cm + 256;
        if (r32 < 16) {
            if (hi == 0) { cm[w * 16 + r32] = m_run; cl[w * 16 + r32] = lt; }
#pragma unroll
            for (int r = 0; r < 16; ++r) { const int d = (r & 3) + 8 * (r >> 2) + 4 * hi; co[(w * 16 + r32) * 64 + d] = o0[r]; co[(w * 16 + r32) * 64 + 32 + d] = o1[r]; }
        }
        __syncthreads();
        {
            const int q = tid >> 5, dp = (tid & 31) * 2;
            float M = cm[q];
#pragma unroll
            for (int ww = 1; ww < 8; ++ww) M = fmaxf(M, cm[ww * 16 + q]);
            float L = 0.f, x0 = 0.f, x1 = 0.f;
#pragma unroll
            for (int ww = 0; ww < 8; ++ww) { const float f = __builtin_amdgcn_exp2f(cm[ww * 16 + q] - M); L += f * cl[ww * 16 + q]; x0 += f * co[(ww * 16 + q) * 64 + dp]; x1 += f * co[(ww * 16 + q) * 64 + dp + 1]; }
            const float inv = 1.f / L;
            *(unsigned*)(Ob + (size_t)q * 512 + dp) = cvtpk(x0 * inv, x1 * inv);
        }
        __syncthreads();
    }
}


DEVI void at_compute(const LAS unsigned char* tb, int r32, int hi, const bf16x8 (&qr)[6], bool first, f32x16& negm, float& m_ref, float& l_run, f32x16& o0, f32x16& o1) {
    const LAS unsigned char* kb = tb + r32 * 208 + hi * 16;
    const LAS unsigned char* vb = tb + AT_KB + r32 * 144 + hi * 16;
    f32x16 p0 = negm, p1 = negm;
    bf16x8 kf[12];
#pragma unroll
    for (int d0 = 0; d0 < 6; ++d0) { kf[2 * d0] = *(const LAS bf16x8*)(kb + d0 * 32); kf[2 * d0 + 1] = *(const LAS bf16x8*)(kb + 32 * 208 + d0 * 32); }
    __builtin_amdgcn_sched_barrier(0);
#pragma unroll
    for (int d0 = 0; d0 < 6; ++d0) { p0 = MFMA32(kf[2 * d0], qr[d0], p0); p1 = MFMA32(kf[2 * d0 + 1], qr[d0], p1); }
    bf16x8 vf[8];
#pragma unroll
    for (int ks = 0; ks < 4; ++ks) { vf[2 * ks] = *(const LAS bf16x8*)(vb + ks * 32); vf[2 * ks + 1] = *(const LAS bf16x8*)(vb + 32 * 144 + ks * 32); }
    __builtin_amdgcn_sched_barrier(0);
    asm volatile("s_nop 15\n\ts_nop 7" : "+v"(p0), "+v"(p1));
    float mxa = max3a(p0[0], p0[1], p1[0]), mxb = max3a(p0[2], p0[3], p1[1]);
    mxa = max3a(mxa, p1[2], p1[3]);
#pragma unroll
    for (int r = 4; r < 16; r += 4) { mxa = max3a(mxa, p0[r], p0[r + 1]); mxb = max3a(mxb, p0[r + 2], p0[r + 3]); mxa = max3a(mxa, p1[r], p1[r + 1]); mxb = max3a(mxb, p1[r + 2], p1[r + 3]); }
    float mx = max2a(mxa, mxb);
    mx = max2a(mx, __shfl_xor(mx, 32));
    if (first || __any(mx > 8.f)) {
        const float d = first ? mx : max2a(mx, 0.f);
        m_ref += d;
        const float alpha = first ? 1.f : __builtin_amdgcn_exp2f(-d);
        l_run *= alpha;
#pragma unroll
        for (int r = 0; r < 16; ++r) { p0[r] -= d; p1[r] -= d; negm[r] -= d; o0[r] *= alpha; o1[r] *= alpha; }
    }
    float rs = 0.f;
#pragma unroll
    for (int r = 0; r < 16; ++r) { p0[r] = __builtin_amdgcn_exp2f(p0[r]); p1[r] = __builtin_amdgcn_exp2f(p1[r]); rs += p0[r] + p1[r]; }
    l_run += rs;
    u32x4 pw[4];
#pragma unroll
    for (int s = 0; s < 2; ++s) {
        pw[s] = (u32x4){cvtpk(p0[8 * s], p0[8 * s + 1]), cvtpk(p0[8 * s + 2], p0[8 * s + 3]), cvtpk(p0[8 * s + 4], p0[8 * s + 5]), cvtpk(p0[8 * s + 6], p0[8 * s + 7])};
        pw[2 + s] = (u32x4){cvtpk(p1[8 * s], p1[8 * s + 1]), cvtpk(p1[8 * s + 2], p1[8 * s + 3]), cvtpk(p1[8 * s + 4], p1[8 * s + 5]), cvtpk(p1[8 * s + 6], p1[8 * s + 7])};
    }
#pragma unroll
    for (int ks = 0; ks < 4; ++ks) {
        const bf16x8 pb = __builtin_bit_cast(bf16x8, pw[ks]);
        o0 = MFMA32(vf[2 * ks], pb, o0); o1 = MFMA32(vf[2 * ks + 1], pb, o1);
    }
}
DEVI void attn_unit_p(int wv, LAS unsigned char* lds, const bf16_t* Qb, const float* ssq_q, const bf16_t* Kb, const bf16_t* VTb, int ldv, int NT, int vis0, bf16_t* Ob) {
    const int tid = TID(), lane = tid & 63, r32 = lane & 31, hi = lane >> 5, w = __builtin_amdgcn_readfirstlane(tid >> 6);
    const int rloc = 32 * w + r32;
    const int lastvis = vis0 + (w >> 1);
    bf16x8 qr[6];
    {
        const float sq = rsqrtf(ssq_q[(size_t)rloc * 8] * (1.f / 96.f) + EPSF) * QSCALE;
#pragma unroll
        for (int d0 = 0; d0 < 6; ++d0) {
            const u32x4 wq = *(const u32x4*)(Qb + (size_t)rloc * 96 + 16 * d0 + 8 * hi);
            const u32x4 pk = pack8(unpk_lo(wq) * sq, unpk_hi(wq) * sq);
            qr[d0] = __builtin_bit_cast(bf16x8, pk);
        }
    }
    const int kp0 = tid, kp1 = 512 + tid;
    const int koff0 = (kp0 / 12) * 208 + (kp0 % 12) * 16, koff1 = (kp1 / 12) * 208 + (kp1 % 12) * 16;
    const int vd = tid >> 3, vc = tid & 7, voffl = AT_KB + vd * 144 + vc * 16;
    const bf16_t* vsrc = VTb + (size_t)vd * ldv + vc * 8;
    const bool two = tid < 256;
    u32x4 ka0, ka1 = {0u, 0u, 0u, 0u}, va, kb0, kb1 = {0u, 0u, 0u, 0u}, vbb;
#define AT_LD(K0, K1, V, t) do { K0 = *(const u32x4*)(Kb + (size_t)(t) * 6144 + kp0 * 8); if (two) K1 = *(const u32x4*)(Kb + (size_t)(t) * 6144 + kp1 * 8); V = *(const u32x4*)(vsrc + (size_t)(t) * 64); } while (0)
#define AT_ST(K0, K1, V, buf) do { LAS unsigned char* b_ = lds + (buf) * AT_TB; *(LAS u32x4*)(b_ + koff0) = K0; if (two) *(LAS u32x4*)(b_ + koff1) = K1; *(LAS u32x4*)(b_ + voffl) = V; } while (0)
    float m_run = 0.f, l_run = 0.f;
    f32x16 o0, o1, negm;
#pragma unroll
    for (int r = 0; r < 16; ++r) { o0[r] = 0.f; o1[r] = 0.f; negm[r] = 0.f; }
    AT_LD(kb0, kb1, vbb, 0); AT_LD(ka0, ka1, va, 1);
    AT_ST(kb0, kb1, vbb, 0);
    __syncthreads();
    for (int t = 0; t < NT; t += 2) {
        if (t + 2 < NT) AT_LD(kb0, kb1, vbb, t + 2);
        if (t <= lastvis) at_compute(lds, r32, hi, qr, t == 0, negm, m_run, l_run, o0, o1);
        AT_ST(ka0, ka1, va, 1);
        __syncthreads();
        if (t + 3 < NT) AT_LD(ka0, ka1, va, t + 3);
        if (t + 1 <= lastvis) at_compute(lds + AT_TB, r32, hi, qr, false, negm, m_run, l_run, o0, o1);
        if (t + 2 < NT) AT_ST(kb0, kb1, vbb, 0);
        __syncthreads();
    }
#undef AT_LD
#undef AT_ST
    const float lt = l_run + __shfl_xor(l_run, 32);
    const float inv = 1.f / lt;
    bf16_t* od = Ob + (size_t)rloc * 512 + 4 * hi;
#pragma unroll
    for (int rg = 0; rg < 4; ++rg) {
        u32x2 a, b; a.x = cvtpk(o0[4 * rg] * inv, o0[4 * rg + 1] * inv); a.y = cvtpk(o0[4 * rg + 2] * inv, o0[4 * rg + 3] * inv);
        b.x = cvtpk(o1[4 * rg] * inv, o1[4 * rg + 1] * inv); b.y = cvtpk(o1[4 * rg + 2] * inv, o1[4 * rg + 3] * inv);
        *(u32x2*)(od + 8 * rg) = a; *(u32x2*)(od + 32 + 8 * rg) = b;
    }
}

constexpr int FS_PITCH = 528, FS_W = 64 * FS_PITCH, FS_COMB = 2 * FS_W, FS_NBLK = 129;
DEVI bf16x8 pk_regs(const f32x16& x, int s, float sc) {
    u32x4 w; w.x = cvtpk(x[8 * s] * sc, x[8 * s + 1] * sc); w.y = cvtpk(x[8 * s + 2] * sc, x[8 * s + 3] * sc); w.z = cvtpk(x[8 * s + 4] * sc, x[8 * s + 5] * sc); w.w = cvtpk(x[8 * s + 6] * sc, x[8 * s + 7] * sc);
    return __builtin_bit_cast(bf16x8, w);
}
DEVI void sample_attn_fused(int wv, LAS unsigned char* lds, int l, int bh) {
    const int tid = TID(), lane = tid & 63, r32 = lane & 31, hi = lane >> 5, w = __builtin_amdgcn_readfirstlane(tid >> 6);
    const int b = bh >> 3, h = bh & 7;
    unsigned char* ws = WSP();
    {
        const bf16_t* wk = (const bf16_t*)(ws + O_W + (size_t)l * W_LAYER + W_KC); const bf16_t* wvv = (const bf16_t*)(ws + O_W + (size_t)l * W_LAYER + W_VC);
        for (int i = tid; i < 4096; i += 512) {
            const int mat = i >> 11, rem = i & 2047, d = rem >> 5, ch = rem & 31;
            const int srow = mat == 0 ? 256 * (h >> 2) + 128 * (d >> 5) + 32 * (h & 3) + (d & 31) : h * 64 + d;
            const u32x4 v = *(const u32x4*)((mat == 0 ? wk : wvv) + (size_t)srow * 256 + ch * 8);
            *(LAS u32x4*)(lds + mat * FS_W + d * FS_PITCH + ch * 16) = v;
        }
    }
    LAS bf16x8* qf = (LAS bf16x8*)(lds + FS_COMB + 34816) + lane;
    {
        bf16x8 qn[4], qrp[2];
        const int qrow = r32 & 15; const size_t tokrow = (size_t)MP + b * 16 + qrow;
        const bf16_t* Qb = (const bf16_t*)(ws + O_QS) + ((size_t)bh * 16 + qrow) * 96;
        const float* gk = IN(12) + l * 96;
        const float sq = rsqrtf(((const float*)(ws + O_SSQZ) + (size_t)(7 + 8 * l) * MT)[tokrow * 8 + h] * (1.f / 96.f) + EPSF) * QSCALE;
#pragma unroll
        for (int f = 0; f < 4; ++f) {
            const int d0 = 32 * (f >> 1) + 16 * (f & 1) + 4 * hi;
            const u32x2 a = *(const u32x2*)(Qb + d0), c = *(const u32x2*)(Qb + d0 + 8);
            const f32x4 ga = *(const f32x4*)(gk + d0) * sq, gc = *(const f32x4*)(gk + d0 + 8) * sq;
            u32x4 pk; pk.x = cvtpk(bflo(a.x) * ga[0], bfhi(a.x) * ga[1]); pk.y = cvtpk(bflo(a.y) * ga[2], bfhi(a.y) * ga[3]);
            pk.z = cvtpk(bflo(c.x) * gc[0], bfhi(c.x) * gc[1]); pk.w = cvtpk(bflo(c.y) * gc[2], bfhi(c.y) * gc[3]);
            qn[f] = __builtin_bit_cast(bf16x8, pk);
        }
#pragma unroll
        for (int s = 0; s < 2; ++s) {
            const int d0 = 64 + 16 * s + 8 * hi;
            const u32x4 a = *(const u32x4*)(Qb + d0);
            const f32x4 g0 = *(const f32x4*)(gk + d0) * sq, g1 = *(const f32x4*)(gk + d0 + 4) * sq;
            const u32x4 pk = pack8(unpk_lo(a) * g0, unpk_hi(a) * g1);
            qrp[s] = __builtin_bit_cast(bf16x8, pk);
        }
        if (w == 0) { qf[0] = qn[0]; qf[64] = qn[1]; qf[128] = qn[2]; qf[192] = qn[3]; qf[256] = qrp[0]; qf[320] = qrp[1]; }
    }
    __syncthreads();
    const bf16_t* cache_c = (const bf16_t*)(ws + O_CKVB) + ((size_t)l * MC + (size_t)b * 4096) * 256;
    const float* cache_r = IN(3) + ((size_t)l * MC + (size_t)b * 4096) * 32;
    const bf16_t* new_c = (const bf16_t*)(ws + O_CKVN) + (size_t)(b * 16 + (r32 & 15)) * 256;
    const float* new_r = OUTP() + OUT_KRS + ((size_t)l * MS + b * 16 + (r32 & 15)) * 32;
#define FS_CP(kb) ((kb) < 128 ? cache_c + (size_t)((kb) * 32 + r32) * 256 + 32 * hi : new_c + 32 * hi)
#define FS_KO(ks) (64 * ((ks) >> 2) + 8 * ((ks) & 3))
#define FS_RP(kb) ((kb) < 128 ? cache_r + (size_t)((kb) * 32 + r32) * 32 + 8 * hi : new_r + 8 * hi)
    bf16x8 cf[16]; f32x4 kr0, kr1, kr2, kr3;
    {
        const bf16_t* cp = FS_CP(w); const float* rp = FS_RP(w);
#pragma unroll
        for (int ks = 0; ks < 16; ++ks) cf[ks] = *(const bf16x8*)(cp + FS_KO(ks));
        kr0 = *(const f32x4*)rp; kr1 = *(const f32x4*)(rp + 4); kr2 = *(const f32x4*)(rp + 16); kr3 = *(const f32x4*)(rp + 20);
    }
    float m_run = -INFINITY, l_run = 0.f;
    f32x16 o0, o1;
#pragma unroll
    for (int r = 0; r < 16; ++r) { o0[r] = 0.f; o1[r] = 0.f; }
    const LAS unsigned char* wkl = lds + r32 * FS_PITCH + hi * 64;
    const LAS unsigned char* wvl = lds + FS_W + r32 * FS_PITCH + hi * 64;
#pragma unroll 1
    for (int kb = w; kb < FS_NBLK; kb += 8) {
        const int nkb = kb + 8; const bool more = nkb < FS_NBLK;
        const bf16_t* ncp = FS_CP(more ? nkb : kb); const float* nrp = FS_RP(more ? nkb : kb);
        f32x16 x0, x1;
#pragma unroll
        for (int r = 0; r < 16; ++r) { x0[r] = 0.f; x1[r] = 0.f; }
#pragma unroll
        for (int ks = 0; ks < 16; ++ks) {
            const bf16x8 a0 = *(const LAS bf16x8*)(wkl + 2 * FS_KO(ks)), a1 = *(const LAS bf16x8*)(wkl + 32 * FS_PITCH + 2 * FS_KO(ks));
            x0 = MFMA32(a0, cf[ks], x0); x1 = MFMA32(a1, cf[ks], x1);
            if ((ks & 3) == 3) __builtin_amdgcn_sched_barrier(0);
        }
        float ss = (ss4(kr0) + ss4(kr1)) + (ss4(kr2) + ss4(kr3));
#pragma unroll
        for (int r = 0; r < 16; ++r) ss += x0[r] * x0[r] + x1[r] * x1[r];
        ss += __shfl_xor(ss, 32);
        const float sk = rsqrtf(ss * (1.f / 96.f) + EPSF);
        f32x16 p;
#pragma unroll
        for (int r = 0; r < 16; ++r) p[r] = 0.f;
        p = MFMA32(pk_regs(x0, 0, sk), qf[0], p); p = MFMA32(pk_regs(x0, 1, sk), qf[64], p);
        p = MFMA32(pk_regs(x1, 0, sk), qf[128], p); p = MFMA32(pk_regs(x1, 1, sk), qf[192], p);
        { const u32x4 k0 = pack8(kr0 * sk, kr1 * sk), k1 = pack8(kr2 * sk, kr3 * sk);
          p = MFMA32(__builtin_bit_cast(bf16x8, k0), qf[256], p); p = MFMA32(__builtin_bit_cast(bf16x8, k1), qf[320], p); }
        if (more) { kr0 = *(const f32x4*)nrp; kr1 = *(const f32x4*)(nrp + 4); kr2 = *(const f32x4*)(nrp + 16); kr3 = *(const f32x4*)(nrp + 20); }
        if (kb == 128) {
#pragma unroll
            for (int r = 8; r < 16; ++r) p[r] = -INFINITY;
        }
        float mx = p[0];
#pragma unroll
        for (int r = 1; r < 16; ++r) mx = fmaxf(mx, p[r]);
        mx = fmaxf(mx, __shfl_xor(mx, 32));
        const float mn = fmaxf(m_run, mx), alpha = __builtin_amdgcn_exp2f(m_run - mn);
        m_run = mn;
        float rs = 0.f;
#pragma unroll
        for (int r = 0; r < 16; ++r) { p[r] = __builtin_amdgcn_exp2f(p[r] - mn); rs += p[r]; }
        l_run = l_run * alpha + rs;
#pragma unroll
        for (int r = 0; r < 16; ++r) { o0[r] *= alpha; o1[r] *= alpha; }
        const bf16x8 pb0 = pk_regs(p, 0, 1.f), pb1 = pk_regs(p, 1, 1.f);
        {
            f32x16 v;
#pragma unroll
            for (int r = 0; r < 16; ++r) v[r] = 0.f;
#pragma unroll
            for (int ks = 0; ks < 16; ++ks) { v = MFMA32(cf[ks], *(const LAS bf16x8*)(wvl + 2 * FS_KO(ks)), v); if ((ks & 3) == 3) __builtin_amdgcn_sched_barrier(0); }
            o0 = MFMA32(pk_regs(v, 0, 1.f), pb0, o0); o0 = MFMA32(pk_regs(v, 1, 1.f), pb1, o0);
        }
        {
            f32x16 v;
#pragma unroll
            for (int r = 0; r < 16; ++r) v[r] = 0.f;
#pragma unroll
            for (int ks = 0; ks < 16; ++ks) {
                v = MFMA32(cf[ks], *(const LAS bf16x8*)(wvl + 32 * FS_PITCH + 2 * FS_KO(ks)), v);
                if (more) cf[ks] = *(const bf16x8*)(ncp + FS_KO(ks));
                if ((ks & 3) == 3) __builtin_amdgcn_sched_barrier(0);
            }
            o1 = MFMA32(pk_regs(v, 0, 1.f), pb0, o1); o1 = MFMA32(pk_regs(v, 1, 1.f), pb1, o1);
        }
    }
#undef FS_CP
#undef FS_KO
#undef FS_RP
    const float lt = l_run + __shfl_xor(l_run, 32);
    LAS float* cm = (LAS float*)(lds + FS_COMB); LAS float* cl = cm + 128; LAS float* co = cm + 256;
    if (r32 < 16) {
        if (hi == 0) { cm[w * 16 + r32] = m_run; cl[w * 16 + r32] = lt; }
#pragma unroll
        for (int r = 0; r < 16; ++r) { const int d = (r & 3) + 8 * (r >> 2) + 4 * hi; co[(w * 16 + r32) * 64 + d] = o0[r]; co[(w * 16 + r32) * 64 + 32 + d] = o1[r]; }
    }
    __syncthreads();
    {
        const int q = tid >> 5, dp = (tid & 31) * 2;
        float M = cm[q];
#pragma unroll
        for (int ww = 1; ww < 8; ++ww) M = fmaxf(M, cm[ww * 16 + q]);
        float L = 0.f, y0 = 0.f, y1 = 0.f;
#pragma unroll
        for (int ww = 0; ww < 8; ++ww) { const float f = __builtin_amdgcn_exp2f(cm[ww * 16 + q] - M); L += f * cl[ww * 16 + q]; y0 += f * co[(ww * 16 + q) * 64 + dp]; y1 += f * co[(ww * 16 + q) * 64 + dp + 1]; }
        const float inv = 1.f / L;
        *(unsigned*)((bf16_t*)(ws + O_ATT) + ((size_t)MP + b * 16 + q) * 512 + h * 64 + dp) = cvtpk(y0 * inv, y1 * inv);
    }
    __syncthreads();
}
static_assert(FS_COMB + 34816 + 6 * 64 * 16 <= LDS_BYTES && (256 + 8 * 16 * 64) * 4 <= 34816, "fused sample attention LDS");

struct Args { const float* in[21]; float* out; unsigned char* ws; };

__device__ const double ROPE_INV[16] = {1.0, 0.5623413251903491, 0.31622776601683794, 0.1778279410038923, 0.1, 0.05623413251903491, 0.03162277660168379, 0.01778279410038923, 0.01, 0.005623413251903491,
                                        0.0031622776601683794, 0.0017782794100389228, 0.001, 0.0005623413251903491, 0.00031622776601683794, 0.00017782794100389227};

DEVI void tr_item(const float* W, int N, int K, const float* gain, bf16_t* WT, int dest0, LAS float* scr, int k0, int n0, int lane) {
#pragma unroll
    for (int i = 0; i < 32; ++i) { const int kk = 2 * i + (lane >> 5); float v = W[(size_t)(k0 + kk) * N + n0 + (lane & 31)]; if (gain) v *= gain[k0 + kk]; scr[kk * 33 + (lane & 31)] = v; }
    asm volatile("s_waitcnt lgkmcnt(0)" ::: "memory");
    const int c = lane & 7;
#pragma unroll
    for (int j = 0; j < 4; ++j) { const int n = (lane >> 3) + 8 * j; const LAS float* s = scr + (8 * c) * 33 + n;
        u32x4 o; o.x = cvtpk(s[0], s[33]); o.y = cvtpk(s[2 * 33], s[3 * 33]); o.z = cvtpk(s[4 * 33], s[5 * 33]); o.w = cvtpk(s[6 * 33], s[7 * 33]);
        *(u32x4*)(WT + (size_t)(dest0 + n) * K + k0 + 8 * c) = o; }
    asm volatile("s_waitcnt lgkmcnt(0)" ::: "memory");
}


template <class Epi>
DEVI void run_gemm(int wv, LAS unsigned char* lds, const bf16_t* A, const bf16_t* Bt, int lda, int ldb, int M, int N, int K, int& off, const Epi& E, int nNr = 0) {
    const int G = GDIM();
    pg8::Gemm g{A, Bt, lda, ldb, K, nNr};
    pg8::StaticOrder S; S.init(M, N, G, (int)((BID() + G - (off % G)) % G));
    pg8::gemm_phase<Epi, pg8::StaticOrder>(wv, lds, g, S, E);
    off += (M / 256) * (N / 256);
}

DEVI void prologue(int wv, LAS unsigned char* lds) {
    const int tid = TID(), lane = tid & 63, wave = __builtin_amdgcn_readfirstlane(tid >> 6);
    const int G = GDIM(), bx = BID();
    const int gw = bx * 8 + wave, NGW = G * 8;
    const size_t gt = (size_t)bx * 512 + tid, NGT = (size_t)G * 512;
    unsigned char* ws = WSP();
    LAS float* scr = (LAS float*)(lds + wave * 8448);
    constexpr int I_IN = 16 * 101, I_UQ = 6 * 24, I_KV = 4 * 32, I_A = 8 * 32, I_O = 16 * 32, I_UP = 16 * 128, I_DN = 64 * 32;
    constexpr int I_L = I_IN + I_UQ + 2 * I_KV + I_A + I_O + I_UP + I_DN;
    for (int it = gw; it < 2 * I_L; it += NGW) {
        const int l = it / I_L; int r = it % I_L;
        unsigned char* wl = ws + O_W + (size_t)l * W_LAYER;
        if (r < I_IN) { const int kb = r / 101, nb = r % 101, n0 = nb * 32;
            const int d0 = n0 < 384 ? n0 : n0 < 640 ? 512 + (n0 - 384) : n0 < 672 ? 384 + (n0 - 640) : n0 < 1184 ? 768 + (n0 - 672) : n0 < 2208 ? 1280 + (n0 - 1184) : 2304 + (n0 - 2208);
            tr_item(IN(6) + (size_t)l * 1024 * 3232, 3232, 1024, IN(5) + l * 1024, (bf16_t*)(wl + W_IN), d0, scr, kb * 64, n0, lane); continue; }
        r -= I_IN;
        if (r < I_UQ) { const int kb = r / 24, nb = r % 24, n0 = nb * 32, hd = n0 / 96, dim0 = n0 % 96;
            const int d0 = dim0 < 64 ? 256 * (hd >> 2) + 128 * (dim0 >> 5) + 32 * (hd & 3) : 512 + 128 * (hd >> 2) + 32 * (hd & 3);
            tr_item(IN(9) + (size_t)l * 384 * 768, 768, 384, IN(7) + l * 384, (bf16_t*)(wl + W_UQ), d0, scr, kb * 64, n0, lane); continue; }
        r -= I_UQ;
        if (r < 2 * I_KV) { const int fold = r < I_KV; if (!fold) r -= I_KV;
            const int kb = r / 32, nb = r % 32, n0 = nb * 32, hd = n0 / 128, dim0 = n0 % 128;
            const bool isk = dim0 < 64;
            const int d0 = isk ? 256 * (hd >> 2) + 128 * (dim0 >> 5) + 32 * (hd & 3) : hd * 64 + (dim0 - 64);
            bf16_t* dst = (bf16_t*)(wl + (fold ? (isk ? W_K : W_V) : (isk ? W_KC : W_VC)));
            tr_item(IN(10) + (size_t)l * 256 * 1024, 1024, 256, fold ? IN(8) + l * 256 : nullptr, dst, d0, scr, kb * 64, n0, lane); continue; }
        r -= 2 * I_KV;
        if (r < I_A) { tr_item(IN(13) + (size_t)l * 512 * 1024, 1024, 512, nullptr, (bf16_t*)(wl + W_A), (r % 32) * 32, scr, (r / 32) * 64, (r % 32) * 32, lane); continue; }
        r -= I_A;
        if (r < I_O) { tr_item(IN(17) + (size_t)l * 1024 * 1024, 1024, 1024, nullptr, (bf16_t*)(wl + W_O), (r % 32) * 32, scr, (r / 32) * 64, (r % 32) * 32, lane); continue; }
        r -= I_O;
        if (r < I_UP) { tr_item(IN(19) + (size_t)l * 1024 * 4096, 4096, 1024, IN(18) + l * 1024, (bf16_t*)(wl + W_UP), (r % 128) * 32, scr, (r / 128) * 64, (r % 128) * 32, lane); continue; }
        r -= I_UP;
        tr_item(IN(20) + (size_t)l * 4096 * 1024, 1024, 4096, nullptr, (bf16_t*)(wl + W_DN), (r % 32) * 32, scr, (r / 32) * 64, (r % 32) * 32, lane);
    }
    for (size_t i = gt; i < (size_t)2 * 96 * 1024 / 8; i += NGT) { const size_t l = i / (96 * 128), rem = i % (96 * 128);
        *(u32x4*)(ws + O_W + l * W_LAYER + W_IN + ((size_t)416 * 1024) * 2 + rem * 16) = (u32x4){0u, 0u, 0u, 0u}; }
    {
        const float* wpool = IN(14); const float* pscale = IN(15); const float* wpo = IN(16);
        for (size_t it = gt; it < (size_t)2 * 65536; it += NGT) {
            const int l = (int)(it >> 16), r = (int)(it & 65535), kc = r >> 10, n = r & 1023, g = kc >> 4, c0 = (kc & 15) * 8;
            const float* wp = wpool + (size_t)l * 4 * 128 * 128 + ((size_t)g * 128 + c0) * 128;
            const float* ps = pscale + l * 512 + g * 128;
            const float* wo = wpo + (size_t)l * 512 * 1024 + (size_t)g * 128 * 1024 + n;
            float a0 = 0.f, a1 = 0.f, a2 = 0.f, a3 = 0.f, a4 = 0.f, a5 = 0.f, a6 = 0.f, a7 = 0.f;
#pragma unroll 16
            for (int e = 0; e < 128; ++e) { const float x = wo[(size_t)e * 1024] * ps[e];
                a0 += wp[e] * x; a1 += wp[128 + e] * x; a2 += wp[256 + e] * x; a3 += wp[384 + e] * x; a4 += wp[512 + e] * x; a5 += wp[640 + e] * x; a6 += wp[768 + e] * x; a7 += wp[896 + e] * x; }
            u32x4 o; o.x = cvtpk(a0, a1); o.y = cvtpk(a2, a3); o.z = cvtpk(a4, a5); o.w = cvtpk(a6, a7);
            *(u32x4*)((bf16_t*)(ws + O_W + (size_t)l * W_LAYER + W_EFF) + (size_t)n * 512 + g * 128 + c0) = o;
        }
    }
    {
        const float* x_p = IN(0); const float* x_s = IN(1); bf16_t* xb = (bf16_t*)(ws + O_XB); float* ssqA0 = (float*)(ws + O_SSQA0);
        for (int row0 = gw; row0 < MT; row0 += 4 * NGW) {
            f32x4 v[4][4];
#pragma unroll
            for (int k = 0; k < 4; ++k) { const int row = row0 + k * NGW;
                if (row < MT) { const float* xr = row < MP ? x_p + (size_t)row * 1024 : x_s + (size_t)(row - MP) * 1024;
#pragma unroll
                    for (int j = 0; j < 4; ++j) v[k][j] = *(const f32x4*)(xr + 256 * j + 4 * lane); } }
#pragma unroll
            for (int k = 0; k < 4; ++k) { const int row = row0 + k * NGW;
                if (row < MT) { float s = 0.f;
#pragma unroll
                    for (int j = 0; j < 4; ++j) { s += ss4(v[k][j]); u32x2 o; o.x = cvtpk(v[k][j][0], v[k][j][1]); o.y = cvtpk(v[k][j][2], v[k][j][3]); *(u32x2*)(xb + (size_t)row * 1024 + 256 * j + 4 * lane) = o; }
#pragma unroll
                    for (int o = 1; o < 64; o <<= 1) s += __shfl_xor(s, o);
                    if (lane == 0) ssqA0[row] = s; } }
        }
    }
    {
        const float* cache_ckv = IN(2); bf16_t* ckvb = (bf16_t*)(ws + O_CKVB);
        for (size_t i = gt; i < (size_t)2 * MC * 256 / 8; i += 8 * NGT) {
            f32x4 a[8], b[8];
#pragma unroll
            for (int k = 0; k < 8; ++k) { const size_t ii = i + k * NGT; if (ii < (size_t)2 * MC * 256 / 8) { a[k] = *(const f32x4*)(cache_ckv + ii * 8); b[k] = *(const f32x4*)(cache_ckv + ii * 8 + 4); } }
#pragma unroll
            for (int k = 0; k < 8; ++k) { const size_t ii = i + k * NGT; if (ii < (size_t)2 * MC * 256 / 8) *(u32x4*)(ckvb + ii * 8) = pack8(a[k], b[k]); }
        }
    }
    { float* ssqz = (float*)(ws + O_SSQZ); for (size_t i = gt; i < SSQZ_FLOATS; i += NGT) ssqz[i] = 0.f; }
}

DEVI void thin_rows(int wv, int l) {
    const int tid = TID(), lane = tid & 63, wave = __builtin_amdgcn_readfirstlane(tid >> 6);
    const int gw = BID() * 8 + wave, NGW = GDIM() * 8;
    unsigned char* ws = WSP(); float* out = OUTP();
    const float* gkva = IN(8) + l * 256;
    const float* sp = IN(4) + (size_t)l * 32 * 15 * 512;
    const float* ssq_zkv = (const float*)(ws + O_SSQZ) + (size_t)(5 + l) * MT;
    const bf16_t* zkv = (const bf16_t*)(ws + O_ZKV); const bf16_t* pp = (const bf16_t*)(ws + O_PP); bf16_t* pooled = (bf16_t*)(ws + O_POOLED);
    float* ockv_p = out + OUT_CKVP + (size_t)l * MP * 256; float* ockv_s = out + OUT_CKVS + (size_t)l * MS * 256;
    for (int c = gw; c < MT / 16; c += NGW) {
        const int r0 = c * 16; const bool samp = r0 >= MP;
        {
            u32x2 z[16]; float sq[16];
#pragma unroll
            for (int i = 0; i < 16; ++i) { z[i] = *(const u32x2*)(zkv + (size_t)(r0 + i) * 256 + 4 * lane); sq[i] = ssq_zkv[r0 + i]; }
            const f32x4 g = *(const f32x4*)(gkva + 4 * lane);
            float* d0 = samp ? ockv_s + (size_t)(r0 - MP) * 256 : ockv_p + (size_t)r0 * 256;
#pragma unroll
            for (int i = 0; i < 16; ++i) {
                const float r = rsqrtf(sq[i] * (1.f / 256.f) + EPSF);
                f32x4 v = {bflo(z[i].x), bfhi(z[i].x), bflo(z[i].y), bfhi(z[i].y)}; v = v * r * g;
                *(f32x4*)(d0 + (size_t)i * 256 + 4 * lane) = v;
                if (samp) { u32x2 o; o.x = cvtpk(v[0], v[1]); o.y = cvtpk(v[2], v[3]); *(u32x2*)((bf16_t*)(ws + O_CKVN) + (size_t)(r0 - MP + i) * 256 + 4 * lane) = o; }
            }
        }
        {
            const int grp = lane >> 4, wsz = 2 << grp, ch = 8 * lane;
            u32x4 rw[31];
            const int t0 = r0 & 4095;
            if (!samp) {
#pragma unroll
                for (int k = 0; k < 15; ++k) rw[k] = (t0 >= 16) ? *(const u32x4*)(pp + (size_t)(r0 - 15 + k) * 512 + ch) : (u32x4){0u, 0u, 0u, 0u};
            } else {
                const float* q = sp + (size_t)((r0 - MP) >> 4) * 15 * 512 + ch;
#pragma unroll
                for (int k = 0; k < 15; ++k) rw[k] = pack8(*(const f32x4*)(q + (size_t)k * 512), *(const f32x4*)(q + (size_t)k * 512 + 4));
            }
#pragma unroll
            for (int k = 15; k < 31; ++k) rw[k] = *(const u32x4*)(pp + (size_t)(r0 + k - 15) * 512 + ch);
            f32x4 s0 = {0.f, 0.f, 0.f, 0.f}, s1 = s0;
#pragma unroll
            for (int j = 0; j < 16; ++j) if (j < wsz) { s0 += unpk_lo(rw[15 - j]); s1 += unpk_hi(rw[15 - j]); }
#pragma unroll
            for (int i = 0; i < 16; ++i) {
                if (i > 0) {
                    const u32x4 od = grp == 0 ? rw[13 + i] : grp == 1 ? rw[11 + i] : grp == 2 ? rw[7 + i] : rw[i - 1];
                    s0 += unpk_lo(rw[15 + i]) - unpk_lo(od); s1 += unpk_hi(rw[15 + i]) - unpk_hi(od);
                }
                const float ic = 1.f / (float)(samp ? wsz : min(wsz, t0 + i + 1));
                *(u32x4*)(pooled + (size_t)(r0 + i) * 512 + ch) = pack8(s0 * ic - unpk_lo(rw[15 + i]), s1 * ic - unpk_hi(rw[15 + i]));
            }
        }
    }
}

DEVI void attn_phase(int wv, LAS unsigned char* lds, int l) {
    const int G = GDIM(), bx = BID();
    const int vcu = (G % 8 == 0) ? (bx % 8) * (G / 8) + bx / 8 : bx;
    for (int pi = vcu; pi < 512; pi += G) {
        const int bh = pi >> 3, s = pi & 7, b = bh >> 3, h = bh & 7;
#pragma unroll 1
        for (int k = 0; k < 2; ++k) {
            unsigned char* ws = WSP();
            const float* ssq_qh = (const float*)(ws + O_SSQZ) + (size_t)(7 + 8 * l) * MT;
            const int qb = k == 0 ? s : 15 - s, q0 = qb * 256; const size_t tok0 = (size_t)b * 4096 + q0;
            attn_unit_p(wv, lds, (const bf16_t*)(ws + O_QP) + ((size_t)bh * 4096 + q0) * 96, ssq_qh + tok0 * 8 + h, (const bf16_t*)(ws + O_KP) + (size_t)bh * 4096 * 96,
                             (const bf16_t*)(ws + O_VTP) + (size_t)bh * 64 * 4096, 4096, 4 * qb + 4, 4 * qb, (bf16_t*)(ws + O_ATT) + tok0 * 512 + h * 64);
        }
    }
    for (int bh = vcu; bh < 256; bh += G) sample_attn_fused(wv, lds, l, bh);
}

static_assert((size_t)16 * MS * 1024 * 4 <= (size_t)MT * (384 + 256) * 2, "split-K partial buffer fits the dead q/kv-latent region");
DEVI void sample_fixup(int wv, int wxb) {
    const int tid = TID(), lane = tid & 63, wave = __builtin_amdgcn_readfirstlane(tid >> 6);
    const int gw = BID() * 8 + wave, NGW = GDIM() * 8;
    unsigned char* ws = WSP(); float* x = OUTP();
    const float* part = (const float*)(ws + O_ZQ);
    bf16_t* xb = (bf16_t*)(ws + O_XB); float* ssqA1 = (float*)(ws + O_SSQZ);
    for (int row = MP + gw; row < MT; row += NGW) {
        float s = 0.f;
#pragma unroll
        for (int j = 0; j < 4; ++j) {
            f32x4 v = *(const f32x4*)(x + (size_t)row * 1024 + 256 * j + 4 * lane);
#pragma unroll
            for (int k = 0; k < 16; ++k) v += *(const f32x4*)(part + ((size_t)k * MS + (row - MP)) * 1024 + 256 * j + 4 * lane);
            *(f32x4*)(x + (size_t)row * 1024 + 256 * j + 4 * lane) = v;
            s += ss4(v);
            if (wxb) { u32x2 o; o.x = cvtpk(v[0], v[1]); o.y = cvtpk(v[2], v[3]); *(u32x2*)(xb + (size_t)row * 1024 + 256 * j + 4 * lane) = o; }
        }
#pragma unroll
        for (int o = 1; o < 64; o <<= 1) s += __shfl_xor(s, o);
        if (wxb && lane == 0) ssqA1[row] = s;
    }
}

#define XB_TMO      128
#define XB_XCNT(j)  (256  + 64 * (j))
#define XB_XSUB(j)  (1280 + 64 * (j))
#define XB_XGEN(j)  (2304 + 64 * (j))
#define XB_TOP      3328
#define XB_TOPGEN   3392
#define XB_SPIN_CAP (1u << 18)
constexpr int LDS_MISC = 131072 + 320;
DEVI unsigned xb_ld(unsigned* p)              { return __hip_atomic_load(p, __ATOMIC_RELAXED, __HIP_MEMORY_SCOPE_AGENT); }
DEVI unsigned xb_add(unsigned* p, unsigned v) { return __hip_atomic_fetch_add(p, v, __ATOMIC_RELAXED, __HIP_MEMORY_SCOPE_AGENT); }
DEVI unsigned xb_xcc_id() { return (unsigned)__builtin_amdgcn_s_getreg((3 << 11) | 20) & 0xFu; }
#define XB_SPIN(cond, bar) do { unsigned _sp = 0; while (cond) { __builtin_amdgcn_s_sleep(1); \
    if ((++_sp & 255u) == 0u) { if (xb_ld(&(bar)[XB_TMO])) break; if (_sp > XB_SPIN_CAP) { atomicAdd(&(bar)[XB_TMO], 1u); break; } } } } while (0)
DEVI void xcd_barrier_post(int wv, LAS unsigned char* lds) {
    if (TID() == 0) {
        unsigned* bar = (unsigned*)(WSP() + O_CTL);
        volatile LAS unsigned* st = (volatile LAS unsigned*)(lds + LDS_MISC);
        st[0] = 0u; st[1] = 0u;
        (void)xb_add(&bar[XB_XCNT(xb_xcc_id())], 1u);
    }
    __syncthreads();
}
DEVI void xcd_barrier_complete(unsigned* bar, unsigned x, unsigned& nloc, unsigned& nx) {
    const unsigned G = (unsigned)gridDim.x;
    unsigned sum, cnt, mine, sp = 0u;
    for (;;) {
        sum = 0u; cnt = 0u; mine = 0u;
#pragma unroll
        for (unsigned j = 0; j < 16; ++j) { const unsigned c = xb_ld(&bar[XB_XCNT(j)]); sum += c; cnt += (c > 0u) ? 1u : 0u; mine = (j == x) ? c : mine; }
        if (sum == G) break;
        __builtin_amdgcn_s_sleep(1);
        if ((++sp & 255u) == 0u) { if (xb_ld(&bar[XB_TMO])) break; if (sp > XB_SPIN_CAP) { atomicAdd(&bar[XB_TMO], 1u); break; } }
    }
    nloc = mine > 0u ? mine : 1u; nx = cnt > 0u ? cnt : 1u;
}
DEVI void grid_bar(int wv, LAS unsigned char* lds) {
    asm volatile("s_waitcnt vmcnt(0)" ::: "memory");
    __syncthreads();
    if (TID() == 0) {
        unsigned* bar = (unsigned*)(WSP() + O_CTL);
        volatile LAS unsigned* st = (volatile LAS unsigned*)(lds + LDS_MISC);
        const unsigned x = xb_xcc_id();
        __builtin_amdgcn_s_waitcnt(0);
        unsigned nloc = st[0], nx = st[1];
        if (nloc == 0u) { xcd_barrier_complete(bar, x, nloc, nx); st[0] = nloc; st[1] = nx; }
        const unsigned old = xb_add(&bar[XB_XSUB(x)], 1u);
        const unsigned gen = old / nloc;
        if (old + 1u == (gen + 1u) * nloc) {
            __builtin_amdgcn_fence(__ATOMIC_RELEASE, "agent");
            asm volatile("s_waitcnt vmcnt(0)" ::: "memory");
            const unsigned og = xb_add(&bar[XB_TOP], 1u);
            const unsigned tg = og / nx;
            if (og + 1u == (tg + 1u) * nx) xb_add(&bar[XB_TOPGEN], 1u);
            else XB_SPIN(xb_ld(&bar[XB_TOPGEN]) == tg, bar);
            __builtin_amdgcn_fence(__ATOMIC_ACQUIRE, "agent");
            xb_add(&bar[XB_XGEN(x)], 1u);
            asm volatile("s_waitcnt vmcnt(0)" ::: "memory");
        } else {
            XB_SPIN(xb_ld(&bar[XB_XGEN(x)]) == gen, bar);
            __builtin_amdgcn_fence(__ATOMIC_ACQUIRE, "agent");
            asm volatile("s_waitcnt vmcnt(0)" ::: "memory");
        }
    }
    __syncthreads();
}

#define WL(l, o) ((const bf16_t*)(WSP() + O_W + (size_t)(l) * W_LAYER + (o)))
#define WSB(o) ((const bf16_t*)(WSP() + (o)))

__global__ void __launch_bounds__(512, 2) fwd_kernel(Args args_unused) {
    extern __shared__ __attribute__((aligned(16))) unsigned char lds_raw[];
    LAS unsigned char* lds = (LAS unsigned char*)lds_raw;
    cg::grid_group grid = cg::this_grid();
    const int wv = __builtin_amdgcn_readfirstlane((int)threadIdx.x >> 6);
    if (BID() == 0) { unsigned* bw = (unsigned*)(WSP() + O_CTL); for (int i = TID(); i < 4096; i += 512) bw[i] = 0u; }
    grid.sync();
    xcd_barrier_post(wv, lds);
    prologue(wv, lds);
    grid_bar(wv, lds);
#pragma unroll 1
    for (int l = 0; l < 2; ++l) {
        int off = 0;
        { EpiZ E{l}; run_gemm(wv, lds, WSB(O_XB), WL(l, W_IN), 1024, 1024, MT, NZ, 1024, off, E); }
        grid_bar(wv, lds);
        { EpiQ E{l}; run_gemm(wv, lds, WSB(O_ZQ), WL(l, W_UQ), 384, 384, MT, 768, 384, off, E); }
        { EpiK E{l, 0}; run_gemm(wv, lds, WSB(O_ZKV), WL(l, W_K), 256, 256, MP, 512, 256, off, E); }
        { EpiVT E{l, 0}; run_gemm(wv, lds, WL(l, W_V), WSB(O_ZKV), 256, 256, 512, MP, 256, off, E); }
        thin_rows(wv, l);
        grid_bar(wv, lds);
        attn_phase(wv, lds, l);
        { EpiGateB E{}; run_gemm(wv, lds, WSB(O_POOLED), WL(l, W_EFF), 512, 512, MT, 1024, 512, off, E); }
        grid_bar(wv, lds);
        { EpiGateA E{}; run_gemm(wv, lds, WSB(O_ATT), WL(l, W_A), 512, 512, MT, 1024, 512, off, E); }
        grid_bar(wv, lds);
        { EpiRes E{l == 0 ? 1 : 0, 1, 1 + l}; run_gemm(wv, lds, WSB(O_GB), WL(l, W_O), 1024, 1024, MT, 1024, 1024, off, E); }
        grid_bar(wv, lds);
        { EpiUp E{l}; run_gemm(wv, lds, WSB(O_XB), WL(l, W_UP), 1024, 1024, MT, DFF, 1024, off, E); }
        grid_bar(wv, lds);
        { EpiRes E{0, l == 0 ? 1 : 0, 0}; run_gemm(wv, lds, WSB(O_AH), WL(l, W_DN), DFF, DFF, MP, 1024, DFF, off, E); }
        { EpiPartS E{}; run_gemm(wv, lds, WSB(O_AH) + (size_t)MP * DFF, WL(l, W_DN), DFF, DFF, MS, 1024 * 16, 256, off, E, 4); }
        grid_bar(wv, lds);
        sample_fixup(wv, l == 0);
        if (l == 0) grid_bar(wv, lds);
    }
}

extern "C" void kernel_launch(void* const* d_in, const int* in_sizes, int n_in, void* d_out, int out_size, void* d_ws, size_t ws_size, hipStream_t stream) {
    static int grid = 0;
    if (grid == 0) {
        if (n_in != 21 || ws_size < O_END2) { fprintf(stderr, "kernel_launch: need 21 inputs and >= %zu bytes of workspace (got %d, %zu)\n", (size_t)O_END2, n_in, ws_size); grid = -1; return; }
        int dev = 0, cus = 0, per_cu = 0;
        (void)hipGetDevice(&dev); (void)hipDeviceGetAttribute(&cus, hipDeviceAttributeMultiprocessorCount, dev);
        (void)hipFuncSetAttribute((const void*)fwd_kernel, hipFuncAttributeMaxDynamicSharedMemorySize, LDS_BYTES);
        (void)hipOccupancyMaxActiveBlocksPerMultiprocessor(&per_cu, (const void*)fwd_kernel, 512, LDS_BYTES);
        if (per_cu < 1) fprintf(stderr, "kernel_launch: occupancy query says %d blocks per CU\n", per_cu);
        (void)hipGetLastError();
        grid = cus;
    }
    if (grid < 0) return;
    Args a{};
    for (int i = 0; i < 21; ++i) a.in[i] = (const float*)d_in[i];
    a.out = (float*)d_out; a.ws = (unsigned char*)d_ws;
    void* params[] = {&a};
    hipError_t e = hipLaunchCooperativeKernel((const void*)fwd_kernel, dim3(grid), dim3(512), params, LDS_BYTES, stream);
    if (e != hipSuccess) fprintf(stderr, "cooperative launch failed: %s (grid %d)\n", hipGetErrorString(e), grid);
}
```

```cpp
#include <hip/hip_runtime.h>
#include <hip/hip_cooperative_groups.h>
#include <cstdio>
#include <cstdint>
namespace cg = cooperative_groups;

#define DEVI __device__ __forceinline__
#define LAS __attribute__((address_space(3)))
__device__ __forceinline__ int opq_v(int x) { asm volatile("" : "+v"(x)); return x; }
__device__ __forceinline__ int opq_s(int x) { asm volatile("" : "+s"(x)); return x; }
__device__ __forceinline__ int tid_now(int wv) { int r; asm volatile("v_mbcnt_lo_u32_b32 %0, -1, 0\n\tv_mbcnt_hi_u32_b32 %0, -1, %0\n\tv_lshl_or_b32 %0, %1, 6, %0" : "=&v"(r) : "s"(wv)); return r; }
#define TID() tid_now(wv)
#define BID() opq_s((int)blockIdx.x)
#define GDIM() opq_s((int)gridDim.x)
typedef unsigned short bf16_t;
typedef short bf16x8 __attribute__((ext_vector_type(8)));
typedef float f32x4 __attribute__((ext_vector_type(4)));
typedef float f32x16 __attribute__((ext_vector_type(16)));
typedef unsigned u32x4 __attribute__((ext_vector_type(4)));
typedef unsigned u32x2 __attribute__((ext_vector_type(2)));
typedef float f32x2_t __attribute__((ext_vector_type(2)));
typedef __bf16 bf16x2_t __attribute__((ext_vector_type(2)));

constexpr int DM = 1024, MP = 32768, MS = 512, MT = MP + MS, MC = 131072, DFF = 4096;
constexpr int NZ = 3328;
constexpr int KSL = 4160;
constexpr float EPSF = 1e-6f;
constexpr float QSCALE = 0.10206207261596575f * 1.4426950408889634f;

DEVI unsigned cvtpk(float lo, float hi) { f32x2_t v = {lo, hi}; bf16x2_t b = __builtin_convertvector(v, bf16x2_t); return __builtin_bit_cast(unsigned, b); }
DEVI u32x4 pack8(const f32x4 a, const f32x4 b) { u32x4 w; w.x = cvtpk(a[0], a[1]); w.y = cvtpk(a[2], a[3]); w.z = cvtpk(b[0], b[1]); w.w = cvtpk(b[2], b[3]); return w; }
DEVI float bflo(unsigned w) { return __uint_as_float(w << 16); }
DEVI float bfhi(unsigned w) { return __uint_as_float(w & 0xffff0000u); }
DEVI f32x4 unpk_lo(const u32x4 w) { return (f32x4){bflo(w.x), bfhi(w.x), bflo(w.y), bfhi(w.y)}; }
DEVI f32x4 unpk_hi(const u32x4 w) { return (f32x4){bflo(w.z), bfhi(w.z), bflo(w.w), bfhi(w.w)}; }
DEVI float ss4(const f32x4 a) { return (a[0] * a[0] + a[1] * a[1]) + (a[2] * a[2] + a[3] * a[3]); }
DEVI float red_fq(float s) { s += __shfl_xor(s, 16); s += __shfl_xor(s, 32); return s; }
DEVI float max3a(float a, float b, float c) { float r; asm("v_max3_f32 %0, %1, %2, %3" : "=v"(r) : "v"(a), "v"(b), "v"(c)); return r; }
DEVI float max2a(float a, float b) { float r; asm("v_max_f32_e32 %0, %1, %2" : "=v"(r) : "v"(a), "v"(b)); return r; }
DEVI float sigm(float x) { return __builtin_amdgcn_rcpf(1.f + __builtin_amdgcn_exp2f(-1.4426950408889634f * x)); }

namespace pg8 {
constexpr int BM = 256, BK = 64, HALF = 128, HTB = HALF * BK * 2, STAGE_BYTES = 8 * HTB, NXCD = 8, WGM = 8;
__host__ __device__ __forceinline__ int lds_byte(int r, int c) { const int st = (r >> 4) * 2 + (c >> 5), rr = r & 15, cc = c & 31, ob = rr * 64 + cc * 2; return st * 1024 + (ob ^ (((ob >> 9) & 1) << 5)); }
__host__ __device__ __forceinline__ void stage_rc(int b, int& R, int& C) { const int st = b / 1024, sb = b % 1024, swz = sb ^ (((sb >> 9) & 1) << 5); R = (st >> 1) * 16 + swz / 64; C = (st & 1) * 32 + (swz % 64) / 2; }
__host__ __device__ __forceinline__ int perm32(int rho) { const int n = rho >> 4, i = rho & 15; return 8 * (i >> 2) + 4 * n + (i & 3); }

struct Unit { int pm, pn, ks; };
struct Gemm { const bf16_t* A; const bf16_t* Bt; int lda, ldb, K, nNr; };

struct StaticOrder {
    int nM, nN, nwg, G, c;
    __device__ void init(int M, int N, int G_, int c_) { nM = M / BM; nN = N / BM; nwg = nM * nN; G = G_; c = c_; }
    __device__ bool next(int i, Unit& u) const {
        const long L = (long)i * G + c; if (L >= nwg) return false;
        int wgid = (int)L; { const int q = nwg / NXCD, r = nwg % NXCD, xcd = wgid % NXCD, off = wgid / NXCD; wgid = (xcd < r ? xcd * (q + 1) : r * (q + 1) + (xcd - r) * q) + off; }
        const int nig = WGM * nN, gid = wgid / nig, fm = gid * WGM, gsz = (nM - fm) < WGM ? (nM - fm) : WGM;
        u.pm = fm + ((wgid % nig) % gsz); u.pn = (wgid % nig) / gsz; return true;
    }
};

template <class Epi, class Sched>
__device__ __forceinline__ void gemm_phase(int wv, LAS unsigned char* lds, const Gemm g, const Sched& S, const Epi& E) {
    const int tid = TID(), wid = __builtin_amdgcn_readfirstlane(tid >> 6), lane = tid & 63, wr = wid >> 2, wc = wid & 3, fr = lane & 15, fq = lane >> 4;
    const int K = g.K, nt = K / BK;
    unsigned voffA[2], voffB[2];
#pragma unroll
    for (int i = 0; i < 2; ++i) { int R, C; stage_rc(tid * 16 + i * 8192, R, C); const int Rb = Epi::PERM ? ((R & ~31) + perm32(R & 31)) : R;
        voffA[i] = (unsigned)(R * g.lda + C) * 2u; voffB[i] = (unsigned)(Rb * g.ldb + C) * 2u; }
    const size_t kstep = (size_t)(BK * 2);
    const unsigned hA = (unsigned)HALF * g.lda * 2u, hB = (unsigned)HALF * g.ldb * 2u;
    const unsigned tA = 2u * hA, tB = 2u * hB;
    const unsigned ldsw = (unsigned)wid * 1024u;
    const int aoff = lds_byte(wr * 64 + fr, fq * 8), boff = lds_byte(wc * 32 + fr, fq * 8);
#define PG8_SA(b, h) (((b) * 2 + (h)) * HTB)
#define PG8_SB(b, h) ((4 + (b) * 2 + (h)) * HTB)
#define PG8_STAGE(bufoff, gbase, voff) do { _Pragma("unroll") for (int _i = 0; _i < 2; ++_i) \
        __builtin_amdgcn_global_load_lds((const unsigned*)((const char*)(gbase) + (voff)[_i]), (LAS unsigned*)(lds + (bufoff) + ldsw + _i * 8192), 16, 0, 0); } while (0)
#define PG8_LDA(dst, b, h) do { _Pragma("unroll") for (int m = 0; m < 4; ++m) _Pragma("unroll") for (int k = 0; k < 2; ++k) dst[m][k] = *(const LAS bf16x8*)(lds + PG8_SA(b, h) + aoff + m * 2048 + k * 1024); } while (0)
#define PG8_LDB(dst, b, h) do { _Pragma("unroll") for (int n = 0; n < 2; ++n) _Pragma("unroll") for (int k = 0; k < 2; ++k) dst[n][k] = *(const LAS bf16x8*)(lds + PG8_SB(b, h) + boff + n * 2048 + k * 1024); } while (0)
#define PG8_MMA(ai, bj, At, Bt) do { __builtin_amdgcn_s_setprio(1); _Pragma("unroll") for (int m = 0; m < 4; ++m) _Pragma("unroll") for (int n = 0; n < 2; ++n) _Pragma("unroll") for (int k = 0; k < 2; ++k) \
        acc[ai][bj][m][n] = __builtin_amdgcn_mfma_f32_16x16x32_bf16(Bt[n][k], At[m][k], acc[ai][bj][m][n], 0, 0, 0); __builtin_amdgcn_s_setprio(0); } while (0)
#define PG8_WAIT_V(n) asm volatile("s_waitcnt vmcnt(" #n ")" ::: "memory")
#define PG8_WAIT_L(n) asm volatile("s_waitcnt lgkmcnt(" #n ")" ::: "memory")
#define PG8_BAR __builtin_amdgcn_s_barrier()
#define PG8_SCHED __builtin_amdgcn_sched_barrier(0)
    Unit cur, nxt; int ui = 0;
    if (!S.next(0, cur)) return;
    f32x4 acc[2][2][4][2];
#pragma unroll
    for (int a = 0; a < 2; ++a)
#pragma unroll
        for (int b = 0; b < 2; ++b)
#pragma unroll
            for (int m = 0; m < 4; ++m)
#pragma unroll
                for (int n = 0; n < 2; ++n) acc[a][b][m][n] = (f32x4){0.f, 0.f, 0.f, 0.f};
    bf16x8 At[4][2], B0[2][2], B1[2][2];
#define PG8_UA(u) ((const char*)g.A + (size_t)(u).pm * tA + (g.nNr ? (size_t)((u).pn / g.nNr) * K * 2 : (size_t)0))
#define PG8_UB(u) ((const char*)g.Bt + (size_t)(g.nNr ? (u).pn % g.nNr : (u).pn) * tB + (g.nNr ? (size_t)((u).pn / g.nNr) * K * 2 : (size_t)0))
    const char* cA = PG8_UA(cur); const char* cB = PG8_UB(cur);
    PG8_STAGE(PG8_SB(0, 0), cB, voffB); PG8_STAGE(PG8_SB(0, 1), cB + hB, voffB); PG8_STAGE(PG8_SA(0, 0), cA, voffA); PG8_STAGE(PG8_SA(0, 1), cA + hA, voffA);
    if (wr == 1) PG8_BAR;
    PG8_WAIT_V(2); PG8_BAR;
    PG8_STAGE(PG8_SB(1, 0), cB + kstep, voffB); PG8_STAGE(PG8_SA(1, 0), cA + kstep, voffA); PG8_STAGE(PG8_SB(1, 1), cB + hB + kstep, voffB);
    PG8_WAIT_V(6); PG8_BAR;
    for (;;) {
        const bool has_next = S.next(ui + 1, nxt);
        const char* nA = has_next ? PG8_UA(nxt) : cA; const char* nB = has_next ? PG8_UB(nxt) : cB;
        for (int t = 0; t < nt; t += 2) {
            const bool last = (t == nt - 2);
            const char* a1 = cA + (size_t)(t + 1) * kstep;
            const char* a2 = last ? nA : cA + (size_t)(t + 2) * kstep; const char* b2 = last ? nB : cB + (size_t)(t + 2) * kstep;
            const char* a3 = a2 + kstep; const char* b3 = b2 + kstep;
            PG8_LDB(B0, 0, 0); PG8_LDB(B1, 0, 1); PG8_SCHED; PG8_LDA(At, 0, 0); PG8_STAGE(PG8_SA(1, 1), a1 + hA, voffA);
            PG8_WAIT_V(8); PG8_WAIT_L(0); PG8_BAR; PG8_MMA(0, 0, At, B0); PG8_MMA(0, 1, At, B1); PG8_BAR; PG8_SCHED;
            PG8_LDA(At, 0, 1); PG8_STAGE(PG8_SB(0, 0), b2, voffB); PG8_STAGE(PG8_SB(0, 1), b2 + hB, voffB); PG8_STAGE(PG8_SA(0, 0), a2, voffA);
            PG8_WAIT_V(8); PG8_WAIT_L(0); PG8_BAR; PG8_MMA(1, 0, At, B0); PG8_MMA(1, 1, At, B1); PG8_BAR; PG8_SCHED;
            PG8_LDB(B0, 1, 0); PG8_LDB(B1, 1, 1); PG8_SCHED; PG8_LDA(At, 1, 0); PG8_STAGE(PG8_SA(0, 1), a2 + hA, voffA);
            PG8_WAIT_V(8); PG8_WAIT_L(0); PG8_BAR; PG8_MMA(0, 0, At, B0); PG8_MMA(0, 1, At, B1); PG8_BAR; PG8_SCHED;
            PG8_LDA(At, 1, 1); PG8_STAGE(PG8_SB(1, 0), b3, voffB); PG8_STAGE(PG8_SB(1, 1), b3 + hB, voffB); PG8_STAGE(PG8_SA(1, 0), a3, voffA);
            PG8_WAIT_V(8); PG8_WAIT_L(0); PG8_BAR; PG8_MMA(1, 0, At, B0); PG8_MMA(1, 1, At, B1); PG8_BAR; PG8_SCHED;
        }
        if (wr == 0) PG8_BAR;
        { const int t2 = TID(), w2 = __builtin_amdgcn_readfirstlane(t2 >> 6), l2 = t2 & 63; Unit eu = cur; eu.ks = 0; if (g.nNr) { eu.pn = cur.pn % g.nNr; eu.ks = cur.pn / g.nNr; } E(acc, eu, w2 >> 2, w2 & 3, l2 & 15, l2 >> 4); }
        if (!has_next) break;
#pragma unroll
        for (int a = 0; a < 2; ++a)
#pragma unroll
            for (int b = 0; b < 2; ++b)
#pragma unroll
                for (int m = 0; m < 4; ++m)
#pragma unroll
                    for (int n = 0; n < 2; ++n) acc[a][b][m][n] = (f32x4){0.f, 0.f, 0.f, 0.f};
        cur = nxt; cA = nA; cB = nB; ++ui;
        if (wr == 1) PG8_BAR;
    }
    PG8_WAIT_V(0);
    PG8_BAR;
#undef PG8_UA
#undef PG8_UB
#undef PG8_SA
#undef PG8_SB
#undef PG8_STAGE
#undef PG8_LDA
#undef PG8_LDB
#undef PG8_MMA
#undef PG8_WAIT_V
#undef PG8_WAIT_L
#undef PG8_BAR
#undef PG8_SCHED
}
}
using pg8::Unit;


constexpr size_t A256(size_t x) { return (x + 255) & ~(size_t)255; }
constexpr size_t O_CTL = 0;
constexpr size_t O_ROPE = 16384;
constexpr size_t O_SSQA0 = O_ROPE + A256((size_t)4112 * 16 * 8);
constexpr size_t O_SSQZ = O_SSQA0 + A256((size_t)MT * 4);
constexpr size_t SSQZ_FLOATS = (size_t)MT * (1 + 2 + 2 + 2 + 16);
constexpr size_t O_W = O_SSQZ + A256(SSQZ_FLOATS * 4);
constexpr size_t W_IN = 0, W_UQ = W_IN + (size_t)NZ * 1024 * 2, W_K = W_UQ + (size_t)768 * 384 * 2, W_V = W_K + 512 * 256 * 2, W_KC = W_V + 512 * 256 * 2, W_VC = W_KC + 512 * 256 * 2,
                 W_A = W_VC + 512 * 256 * 2, W_EFF = W_A + 1024 * 512 * 2, W_O = W_EFF + 1024 * 512 * 2, W_UP = W_O + 1024 * 1024 * 2, W_DN = W_UP + (size_t)4096 * 1024 * 2, W_LAYER = W_DN + (size_t)4096 * 1024 * 2;
constexpr size_t O_CKVB = O_W + 2 * W_LAYER;
constexpr size_t O_XB = O_CKVB + (size_t)2 * MC * 256 * 2;
constexpr size_t O_ZQ = O_XB + (size_t)MT * 1024 * 2;
constexpr size_t O_ZKV = O_ZQ + (size_t)MT * 384 * 2;
constexpr size_t O_PP = O_ZKV + (size_t)MT * 256 * 2;
constexpr size_t O_GA = O_PP + (size_t)MT * 512 * 2;
constexpr size_t O_GB = O_GA + (size_t)MT * 1024 * 2;
constexpr size_t O_POOLED = O_GB + (size_t)MT * 1024 * 2;
constexpr size_t O_QP = O_POOLED + (size_t)MT * 512 * 2;
constexpr size_t O_QS = O_QP + (size_t)MP * 768 * 2;
constexpr size_t O_KP = O_QS + (size_t)MS * 768 * 2;
constexpr size_t O_VTP = O_KP + (size_t)MP * 768 * 2;
constexpr size_t O_ATT = O_VTP + (size_t)MP * 512 * 2;
constexpr size_t O_KS = O_ATT + (size_t)MT * 512 * 2;
constexpr size_t O_VTS = O_KS + (size_t)256 * KSL * 96 * 2;
constexpr size_t O_END = O_VTS + (size_t)256 * 64 * KSL * 2;
constexpr size_t O_CKVN = O_END;
constexpr size_t O_END2 = O_CKVN + (size_t)MS * 256 * 2;
constexpr size_t O_AH = O_KS;
static_assert((size_t)MT * DFF * 2 <= O_END - O_KS, "FFN hidden overlay");

constexpr size_t OUT_Y = 0, OUT_CKVP = (size_t)MT * 1024, OUT_KRP = OUT_CKVP + (size_t)2 * MP * 256, OUT_PLP = OUT_KRP + (size_t)2 * MP * 32, OUT_CKVS = OUT_PLP + (size_t)2 * 8 * 15 * 512,
                 OUT_KRS = OUT_CKVS + (size_t)2 * MS * 256, OUT_PLS = OUT_KRS + (size_t)2 * MS * 32;

constexpr int LDS_BYTES = 147456;

typedef const __attribute__((address_space(4))) unsigned char* karg_t;
DEVI karg_t kargs() { karg_t p = (karg_t)__builtin_amdgcn_kernarg_segment_ptr(); asm volatile("" : "+s"(p)); return p; }
DEVI const float* IN(int i) { return *(const float* const __attribute__((address_space(4)))*)(kargs() + 8 * i); }
DEVI float* OUTP() { return *(float* const __attribute__((address_space(4)))*)(kargs() + 8 * 21); }
DEVI unsigned char* WSP() { return *(unsigned char* const __attribute__((address_space(4)))*)(kargs() + 8 * 22); }
#define FENCE() asm volatile("" ::: "memory")

DEVI void rope_cs(int pos, int half, int j, float& c, float& s) {
    constexpr float KREV[8] = {0.15915494309189535f, 0.08949940160889101f, 0.050329212104487035f, 0.0283021958306234f, 0.015915494309189534f, 0.008949940160889102f, 0.005032921210448704f, 0.00283021958306234f};
    const float rev = __builtin_amdgcn_fractf((float)pos * (KREV[j] * (half ? 0.01f : 1.f)));
    c = __builtin_amdgcn_cosf(rev); s = __builtin_amdgcn_sinf(rev);
}

typedef const f32x4 (&AccRef)[2][2][4][2];
#define ROWLOOP _Pragma("unroll") for (int ai = 0; ai < 2; ++ai) _Pragma("unroll") for (int m = 0; m < 4; ++m)
#define ROWOF(u) ((u).pm * 256 + ai * 128 + wr * 64 + m * 16 + fr)

struct EpiZ {
    static constexpr bool PERM = true;
    int l;
    DEVI void operator()(AccRef acc, const Unit& u, int wr, int wc, int fr, int fq) const {
        unsigned char* ws = WSP(); float* out = OUTP();
        const float* ssqx = (const float*)(ws + (l == 0 ? O_SSQA0 : O_SSQZ));
        float* ssqz = (float*)(ws + O_SSQZ);
        const int pn = u.pn, cw = wc * 32 + 8 * fq;
        float rq[2][4];
        ROWLOOP rq[ai][m] = ssqx[ROWOF(u)];
        ROWLOOP {
            const int row = ROWOF(u);
            const float r = rsqrtf(rq[ai][m] * (1.f / 1024.f) + EPSF);
            const f32x4 v00 = acc[ai][0][m][0] * r, v01 = acc[ai][0][m][1] * r, v10 = acc[ai][1][m][0] * r, v11 = acc[ai][1][m][1] * r;
            if (pn == 0) {
                bf16_t* zq = (bf16_t*)(ws + O_ZQ) + (size_t)row * 384 + cw;
                *(u32x4*)zq = pack8(v00, v01); *(u32x4*)(zq + 128) = pack8(v10, v11);
                const float s = red_fq((ss4(v00) + ss4(v01)) + (ss4(v10) + ss4(v11)));
                if (fq == 0) unsafeAtomicAdd(ssqz + (size_t)(3 + l) * MT + row, s);
            } else if (pn == 1) {
                bf16_t* zq = (bf16_t*)(ws + O_ZQ) + (size_t)row * 384 + 256 + cw;
                *(u32x4*)zq = pack8(v00, v01);
                const float s = red_fq(ss4(v00) + ss4(v01));
                if (fq == 0) unsafeAtomicAdd(ssqz + (size_t)(3 + l) * MT + row, s);
                if (wc == 0) {
                    const int pos = row < MP ? (row & 4095) : 4096 + ((row - MP) & 15);
                    float* dst = row < MP ? out + OUT_KRP + ((size_t)l * MP + row) * 32 : out + OUT_KRS + ((size_t)l * MS + (row - MP)) * 32;
                    const float sg = fq < 2 ? -1.f : 1.f;
                    f32x4 o0, o1;
#pragma unroll
                    for (int j = 0; j < 4; ++j) { float cc, sn; rope_cs(pos, fq & 1, j, cc, sn); const float ot = __shfl_xor(v10[j], 32); o0[j] = v10[j] * cc + sg * ot * sn; }
#pragma unroll
                    for (int j = 0; j < 4; ++j) { float cc, sn; rope_cs(pos, fq & 1, 4 + j, cc, sn); const float ot = __shfl_xor(v11[j], 32); o1[j] = v11[j] * cc + sg * ot * sn; }
                    *(f32x4*)(dst + 8 * fq) = o0; *(f32x4*)(dst + 8 * fq + 4) = o1;
                }
            } else if (pn == 2) {
                bf16_t* zkv = (bf16_t*)(ws + O_ZKV) + (size_t)row * 256 + cw;
                *(u32x4*)zkv = pack8(v00, v01); *(u32x4*)(zkv + 128) = pack8(v10, v11);
                const float s = red_fq((ss4(v00) + ss4(v01)) + (ss4(v10) + ss4(v11)));
                if (fq == 0) unsafeAtomicAdd(ssqz + (size_t)(5 + l) * MT + row, s);
            } else if (pn <= 4) {
                const int col = (pn - 3) * 256 + cw;
                bf16_t* pp = (bf16_t*)(ws + O_PP) + (size_t)row * 512 + col;
                *(u32x4*)pp = pack8(v00, v01); *(u32x4*)(pp + 128) = pack8(v10, v11);
                float* pd = nullptr;
                if (row < MP) { const int t = row & 4095; if (t >= 4081) pd = out + OUT_PLP + ((size_t)l * 8 * 15 + (row >> 12) * 15 + (t - 4081)) * 512; }
                else { const int rr = row - MP, i = rr & 15; if (i >= 1) pd = out + OUT_PLS + ((size_t)l * 32 * 15 + (rr >> 4) * 15 + (i - 1)) * 512; }
                if (pd) { *(f32x4*)(pd + col) = v00; *(f32x4*)(pd + col + 4) = v01; *(f32x4*)(pd + col + 128) = v10; *(f32x4*)(pd + col + 132) = v11; }
            } else {
                bf16_t* g = (bf16_t*)(ws + (pn <= 8 ? O_GA : O_GB)) + (size_t)row * 1024 + ((pn - 5) & 3) * 256 + cw;
                f32x4 a, b, c, d;
#pragma unroll
                for (int j = 0; j < 4; ++j) { a[j] = sigm(v00[j]); b[j] = sigm(v01[j]); c[j] = sigm(v10[j]); d[j] = sigm(v11[j]); }
                *(u32x4*)g = pack8(a, b); *(u32x4*)(g + 128) = pack8(c, d);
            }
            FENCE();
        }
    }
};

DEVI bf16_t* q_ptr(unsigned char* ws, int row, int hd) {
    if (row < MP) return (bf16_t*)(ws + O_QP) + ((size_t)((row >> 12) * 8 + hd) * 4096 + (row & 4095)) * 96;
    const int rr = row - MP; return (bf16_t*)(ws + O_QS) + ((size_t)((rr >> 4) * 8 + hd) * 16 + (rr & 15)) * 96;
}
struct EpiQ {
    static constexpr bool PERM = true;
    int l;
    DEVI void operator()(AccRef acc, const Unit& u, int wr, int wc, int fr, int fq) const {
        unsigned char* ws = WSP(); const float* gq = IN(11) + l * 96;
        const float* ssq_zq = (const float*)(ws + O_SSQZ) + (size_t)(3 + l) * MT;
        float* ssq_qh = (float*)(ws + O_SSQZ) + (size_t)(7 + 8 * l) * MT;
        const int pn = u.pn;
        const f32x4 gA = *(const f32x4*)(gq + (pn < 2 ? 0 : 64) + 8 * fq), gB = *(const f32x4*)(gq + (pn < 2 ? 4 : 68) + 8 * fq), gC = *(const f32x4*)(gq + 32 + 8 * fq), gD = *(const f32x4*)(gq + 36 + 8 * fq);
        float rq[2][4];
        ROWLOOP rq[ai][m] = ssq_zq[ROWOF(u)];
        ROWLOOP {
            const int row = ROWOF(u);
            const float r = rsqrtf(rq[ai][m] * (1.f / 384.f) + EPSF);
            const f32x4 v00 = acc[ai][0][m][0] * r, v01 = acc[ai][0][m][1] * r, v10 = acc[ai][1][m][0] * r, v11 = acc[ai][1][m][1] * r;
            if (pn < 2) {
                const int hd = 4 * pn + wc;
                const float s = red_fq((ss4(v00) + ss4(v01)) + (ss4(v10) + ss4(v11)));
                if (fq == 0) unsafeAtomicAdd(ssq_qh + (size_t)row * 8 + hd, s);
                bf16_t* qd = q_ptr(ws, row, hd);
                *(u32x4*)(qd + 8 * fq) = pack8(v00 * gA, v01 * gB); *(u32x4*)(qd + 32 + 8 * fq) = pack8(v10 * gC, v11 * gD);
            } else {
                const int pos = row < MP ? (row & 4095) : 4096 + ((row - MP) & 15);
                const float sg = fq < 2 ? -1.f : 1.f;
                float cs[8], sn[8];
#pragma unroll
                for (int j = 0; j < 8; ++j) rope_cs(pos, fq & 1, j, cs[j], sn[j]);
                const f32x4 g0 = gA, g1 = gB;
#pragma unroll
                for (int bj = 0; bj < 2; ++bj) {
                    const f32x4 x0 = bj ? v10 : v00, x1 = bj ? v11 : v01;
                    const int hd = 4 * bj + wc;
                    const float s = red_fq(ss4(x0) + ss4(x1));
                    if (fq == 0) unsafeAtomicAdd(ssq_qh + (size_t)row * 8 + hd, s);
                    f32x4 o0, o1;
#pragma unroll
                    for (int j = 0; j < 4; ++j) { const float ot = __shfl_xor(x0[j], 32); o0[j] = x0[j] * cs[j] + sg * ot * sn[j]; }
#pragma unroll
                    for (int j = 0; j < 4; ++j) { const float ot = __shfl_xor(x1[j], 32); o1[j] = x1[j] * cs[4 + j] + sg * ot * sn[4 + j]; }
                    *(u32x4*)(q_ptr(ws, row, hd) + 64 + 8 * fq) = pack8(o0 * g0, o1 * g1);
                }
            }
            FENCE();
        }
    }
};

struct EpiK {
    static constexpr bool PERM = true;
    int l, cache;
    DEVI void operator()(AccRef acc, const Unit& u, int wr, int wc, int fr, int fq) const {
        unsigned char* ws = WSP(); const float* gk = IN(12) + l * 96;
        const float* krc = cache ? IN(3) + (size_t)l * MC * 32 : OUTP();
        const float* ssq_zkv = (const float*)(ws + O_SSQZ) + (size_t)(5 + l) * MT;
        const int hd = 4 * u.pn + wc;
        const bool samp = !cache && (u.pm * 256 >= MP);
        bf16_t* kbase = (bf16_t*)(ws + ((cache || samp) ? O_KS : O_KP));
#pragma unroll
        for (int ai = 0; ai < 2; ++ai) {
            f32x4 k0[4], k1[4]; float rr[4]; unsigned ko[4];
#pragma unroll
            for (int m = 0; m < 4; ++m) {
                const int row = ROWOF(u);
                const float* krp;
                if (cache) { krp = krc + (size_t)row * 32; ko[m] = ((unsigned)((row >> 12) * 8 + hd) * KSL + (row & 4095)) * 96u; rr[m] = 1.f; }
                else {
                    rr[m] = ssq_zkv[row];
                    if (!samp) { krp = krc + OUT_KRP + ((size_t)l * MP + row) * 32; ko[m] = ((unsigned)((row >> 12) * 8 + hd) * 4096u + (row & 4095)) * 96u; }
                    else { const int rw = row - MP; krp = krc + OUT_KRS + ((size_t)l * MS + rw) * 32; ko[m] = ((unsigned)((rw >> 4) * 8 + hd) * KSL + 4096u + (rw & 15)) * 96u; }
                }
                k0[m] = *(const f32x4*)(krp + 8 * fq); k1[m] = *(const f32x4*)(krp + 8 * fq + 4);
            }
            const f32x4 g0 = *(const f32x4*)(gk + 8 * fq), g1 = *(const f32x4*)(gk + 8 * fq + 4), g2 = *(const f32x4*)(gk + 32 + 8 * fq), g3 = *(const f32x4*)(gk + 36 + 8 * fq),
                        g4 = *(const f32x4*)(gk + 64 + 8 * fq), g5 = *(const f32x4*)(gk + 68 + 8 * fq);
#pragma unroll
            for (int m = 0; m < 4; ++m) {
                const float r = cache ? 1.f : rsqrtf(rr[m] * (1.f / 256.f) + EPSF);
                const f32x4 v00 = acc[ai][0][m][0] * r, v01 = acc[ai][0][m][1] * r, v10 = acc[ai][1][m][0] * r, v11 = acc[ai][1][m][1] * r;
                const float s = red_fq(((ss4(v00) + ss4(v01)) + (ss4(v10) + ss4(v11))) + (ss4(k0[m]) + ss4(k1[m])));
                const float sc = rsqrtf(s * (1.f / 96.f) + EPSF);
                bf16_t* kd = kbase + ko[m];
                *(u32x4*)(kd + 8 * fq) = pack8(v00 * (g0 * sc), v01 * (g1 * sc));
                *(u32x4*)(kd + 32 + 8 * fq) = pack8(v10 * (g2 * sc), v11 * (g3 * sc));
                *(u32x4*)(kd + 64 + 8 * fq) = pack8(k0[m] * (g4 * sc), k1[m] * (g5 * sc));
            }
            FENCE();
        }
    }
};

struct EpiVT {
    static constexpr bool PERM = true;
    int l, cache;
    DEVI void operator()(AccRef acc, const Unit& u, int wr, int wc, int fr, int fq) const {
        unsigned char* ws = WSP();
        const float* ssq_zkv = (const float*)(ws + O_SSQZ) + (size_t)(5 + l) * MT;
        const bool samp = !cache && (u.pn * 256 >= MP);
        bf16_t* vbase = (bf16_t*)(ws + ((cache || samp) ? O_VTS : O_VTP));
        const unsigned ld = (cache || samp) ? KSL : 4096;
#pragma unroll
        for (int bj = 0; bj < 2; ++bj) {
            const int tok0 = u.pn * 256 + bj * 128 + wc * 32 + 8 * fq;
            f32x4 r0 = {1.f, 1.f, 1.f, 1.f}, r1 = r0;
            unsigned pos;
            if (!cache) {
                const f32x4 s0 = *(const f32x4*)(ssq_zkv + tok0), s1 = *(const f32x4*)(ssq_zkv + tok0 + 4);
#pragma unroll
                for (int j = 0; j < 4; ++j) { r0[j] = rsqrtf(s0[j] * (1.f / 256.f) + EPSF); r1[j] = rsqrtf(s1[j] * (1.f / 256.f) + EPSF); }
            }
            if (samp) { const int rr = tok0 - MP; pos = (unsigned)(rr >> 4) * 512u * ld + 4096u + ((rr & 8) ? 4u : 0u); }
            else pos = (unsigned)(tok0 >> 12) * 512u * ld + (unsigned)((tok0 & 4095) & ~15) + ((tok0 & 8) ? 4u : 0u);
            ROWLOOP {
                const int c = ROWOF(u);
                const f32x4 a = acc[ai][bj][m][0] * r0, b = acc[ai][bj][m][1] * r1;
                bf16_t* d = vbase + (pos + (unsigned)c * ld);
                u32x2 w0, w1; w0.x = cvtpk(a[0], a[1]); w0.y = cvtpk(a[2], a[3]); w1.x = cvtpk(b[0], b[1]); w1.y = cvtpk(b[2], b[3]);
                *(u32x2*)d = w0; *(u32x2*)(d + 8) = w1;
                FENCE();
            }
        }
    }
};

struct EpiGateB {
    static constexpr bool PERM = true;
    DEVI void operator()(AccRef acc, const Unit& u, int wr, int wc, int fr, int fq) const {
        bf16_t* gb = (bf16_t*)(WSP() + O_GB);
#pragma unroll
        for (int ai = 0; ai < 2; ++ai) {
            u32x4 w[4][2];
#pragma unroll
            for (int m = 0; m < 4; ++m)
#pragma unroll
                for (int bj = 0; bj < 2; ++bj) w[m][bj] = *(const u32x4*)(gb + (unsigned)ROWOF(u) * 1024u + u.pn * 256 + bj * 128 + wc * 32 + 8 * fq);
#pragma unroll
            for (int m = 0; m < 4; ++m)
#pragma unroll
                for (int bj = 0; bj < 2; ++bj)
                    *(u32x4*)(gb + (unsigned)ROWOF(u) * 1024u + u.pn * 256 + bj * 128 + wc * 32 + 8 * fq) = pack8(acc[ai][bj][m][0] * unpk_lo(w[m][bj]), acc[ai][bj][m][1] * unpk_hi(w[m][bj]));
            FENCE();
        }
    }
};
struct EpiGateA {
    static constexpr bool PERM = true;
    DEVI void operator()(AccRef acc, const Unit& u, int wr, int wc, int fr, int fq) const {
        unsigned char* ws = WSP();
        const bf16_t* ga = (const bf16_t*)(ws + O_GA); bf16_t* mb = (bf16_t*)(ws + O_GB);
#pragma unroll
        for (int ai = 0; ai < 2; ++ai) {
            u32x4 g[4][2], w[4][2];
#pragma unroll
            for (int m = 0; m < 4; ++m)
#pragma unroll
                for (int bj = 0; bj < 2; ++bj) { const unsigned off = (unsigned)ROWOF(u) * 1024u + u.pn * 256 + bj * 128 + wc * 32 + 8 * fq; g[m][bj] = *(const u32x4*)(ga + off); w[m][bj] = *(const u32x4*)(mb + off); }
#pragma unroll
            for (int m = 0; m < 4; ++m)
#pragma unroll
                for (int bj = 0; bj < 2; ++bj) { const unsigned off = (unsigned)ROWOF(u) * 1024u + u.pn * 256 + bj * 128 + wc * 32 + 8 * fq;
                    *(u32x4*)(mb + off) = pack8(acc[ai][bj][m][0] * unpk_lo(g[m][bj]) + unpk_lo(w[m][bj]), acc[ai][bj][m][1] * unpk_hi(g[m][bj]) + unpk_hi(w[m][bj])); }
            FENCE();
        }
    }
};
struct EpiRes {
    static constexpr bool PERM = true;
    int from_in, wxb, ssq_slot;
    DEVI void operator()(AccRef acc, const Unit& u, int wr, int wc, int fr, int fq) const {
        unsigned char* ws = WSP(); float* out = OUTP();
        const bool samp = u.pm * 256 >= MP;
        const float* base = from_in ? (samp ? IN(1) - (size_t)MP * 1024 : IN(0)) : out;
        bf16_t* xb = (bf16_t*)(ws + O_XB); float* ssq = (float*)(ws + O_SSQZ) + (size_t)ssq_slot * MT;
#pragma unroll
        for (int ai = 0; ai < 2; ++ai) {
            f32x4 b0[4][2], b1[4][2];
#pragma unroll
            for (int m = 0; m < 4; ++m)
#pragma unroll
                for (int bj = 0; bj < 2; ++bj) { const float* bp = base + (unsigned)ROWOF(u) * 1024u + u.pn * 256 + bj * 128 + wc * 32 + 8 * fq; b0[m][bj] = *(const f32x4*)bp; b1[m][bj] = *(const f32x4*)(bp + 4); }
#pragma unroll
            for (int m = 0; m < 4; ++m) {
                const int row = ROWOF(u);
                float s = 0.f;
#pragma unroll
                for (int bj = 0; bj < 2; ++bj) {
                    const unsigned off = (unsigned)row * 1024u + u.pn * 256 + bj * 128 + wc * 32 + 8 * fq;
                    const f32x4 o0 = b0[m][bj] + acc[ai][bj][m][0], o1 = b1[m][bj] + acc[ai][bj][m][1];
                    *(f32x4*)(out + off) = o0; *(f32x4*)(out + off + 4) = o1;
                    if (wxb) { *(u32x4*)(xb + off) = pack8(o0, o1); s += ss4(o0) + ss4(o1); }
                }
                if (wxb) { s = red_fq(s); if (fq == 0) unsafeAtomicAdd(ssq + row, s); }
            }
            FENCE();
        }
    }
};
struct EpiPartS {
    static constexpr bool PERM = true;
    DEVI void operator()(AccRef acc, const Unit& u, int wr, int wc, int fr, int fq) const {
        float* part = (float*)(WSP() + O_ZQ) + (size_t)u.ks * MS * 1024;
        ROWLOOP {
            const int row = ROWOF(u);
#pragma unroll
            for (int bj = 0; bj < 2; ++bj) {
                float* o = part + (unsigned)row * 1024u + u.pn * 256 + bj * 128 + wc * 32 + 8 * fq;
                *(f32x4*)o = acc[ai][bj][m][0]; *(f32x4*)(o + 4) = acc[ai][bj][m][1];
            }
        }
    }
};
struct EpiUp {
    static constexpr bool PERM = true;
    int l;
    DEVI void operator()(AccRef acc, const Unit& u, int wr, int wc, int fr, int fq) const {
        unsigned char* ws = WSP();
        const float* ssq = (const float*)(ws + O_SSQZ) + (size_t)(1 + l) * MT; bf16_t* ah = (bf16_t*)(ws + O_AH);
        ROWLOOP {
            const int row = ROWOF(u);
            const float r = rsqrtf(ssq[row] * (1.f / 1024.f) + EPSF);
#pragma unroll
            for (int bj = 0; bj < 2; ++bj) {
                f32x4 a = acc[ai][bj][m][0] * r, b = acc[ai][bj][m][1] * r;
#pragma unroll
                for (int j = 0; j < 4; ++j) { const float x = fmaxf(a[j], 0.f), y = fmaxf(b[j], 0.f); a[j] = x * x; b[j] = y * y; }
                *(u32x4*)(ah + (size_t)row * DFF + u.pn * 256 + bj * 128 + wc * 32 + 8 * fq) = pack8(a, b);
            }
        }
    }
};

constexpr int AT_KB = 64 * 208, AT_VB = 64 * 144, AT_TB = AT_KB + AT_VB;
#define MFMA32(a, b, c) __builtin_amdgcn_mfma_f32_32x32x16_bf16((a), (b), (c), 0, 0, 0)
template <bool SAMPLE>
DEVI void attn_unit(int wv, LAS unsigned char* lds, const bf16_t* Qb, const float* ssq_q, const bf16_t* Kb, const bf16_t* VTb, int ldv, int NT, int vis0, bf16_t* Ob) {
    const int tid = TID(), lane = tid & 63, r32 = lane & 31, hi = lane >> 5, w = __builtin_amdgcn_readfirstlane(tid >> 6);
    const int rloc = SAMPLE ? (r32 & 15) : 32 * w + r32;
    const int lastvis = SAMPLE ? NT : vis0 + (w >> 1);
    bf16x8 qr[6];
    {
        const float sq = rsqrtf(ssq_q[(size_t)rloc * 8] * (1.f / 96.f) + EPSF) * QSCALE;
#pragma unroll
        for (int d0 = 0; d0 < 6; ++d0) {
            const u32x4 wv = *(const u32x4*)(Qb + (size_t)rloc * 96 + 16 * d0 + 8 * hi);
            const u32x4 pk = pack8(unpk_lo(wv) * sq, unpk_hi(wv) * sq);
            qr[d0] = __builtin_bit_cast(bf16x8, pk);
        }
    }
    const int kp0 = tid, kp1 = 512 + tid;
    const int koff0 = (kp0 / 12) * 208 + (kp0 % 12) * 16, koff1 = (kp1 / 12) * 208 + (kp1 % 12) * 16;
    const int vd = tid >> 3, vc = tid & 7, voffl = AT_KB + vd * 144 + vc * 16;
    const bf16_t* vsrc = VTb + (size_t)vd * ldv + vc * 8;
    u32x4 kr0, kr1 = {0u, 0u, 0u, 0u}, vr;
#define AT_LOAD(t) do { kr0 = *(const u32x4*)(Kb + (size_t)(t) * 6144 + kp0 * 8); if (tid < 256) kr1 = *(const u32x4*)(Kb + (size_t)(t) * 6144 + kp1 * 8); vr = *(const u32x4*)(vsrc + (size_t)(t) * 64); } while (0)
#define AT_STORE(buf) do { LAS unsigned char* b_ = lds + (buf) * AT_TB; *(LAS u32x4*)(b_ + koff0) = kr0; if (tid < 256) *(LAS u32x4*)(b_ + koff1) = kr1; *(LAS u32x4*)(b_ + voffl) = vr; } while (0)
    float m_run = -INFINITY, l_run = 0.f;
    f32x16 o0, o1;
#pragma unroll
    for (int r = 0; r < 16; ++r) { o0[r] = 0.f; o1[r] = 0.f; }
    AT_LOAD(0); AT_STORE(0);
    __syncthreads();
    for (int t = 0; t < NT; ++t) {
        if (t + 1 < NT) AT_LOAD(t + 1);
        const bool active = SAMPLE ? ((t & 7) == w) : (t <= lastvis);
        if (active) {
            const LAS unsigned char* kb = lds + (t & 1) * AT_TB + r32 * 208 + hi * 16;
            const LAS unsigned char* vb = lds + (t & 1) * AT_TB + AT_KB + r32 * 144 + hi * 16;
            f32x16 p0, p1;
#pragma unroll
            for (int r = 0; r < 16; ++r) { p0[r] = 0.f; p1[r] = 0.f; }
#pragma unroll
            for (int d0 = 0; d0 < 6; ++d0) {
                const bf16x8 a0 = *(const LAS bf16x8*)(kb + d0 * 32), a1 = *(const LAS bf16x8*)(kb + 32 * 208 + d0 * 32);
                p0 = MFMA32(a0, qr[d0], p0); p1 = MFMA32(a1, qr[d0], p1);
            }
            if (SAMPLE && t == NT - 1) {
#pragma unroll
                for (int r = 0; r < 16; ++r) { if (r >= 8) p0[r] = -INFINITY; p1[r] = -INFINITY; }
            }
            float mx = fmaxf(p0[0], p1[0]);
#pragma unroll
            for (int r = 1; r < 16; ++r) mx = fmaxf(mx, fmaxf(p0[r], p1[r]));
            mx = fmaxf(mx, __shfl_xor(mx, 32));
            const float mn = fmaxf(m_run, mx), alpha = __builtin_amdgcn_exp2f(m_run - mn);
            m_run = mn;
            float rs = 0.f;
#pragma unroll
            for (int r = 0; r < 16; ++r) { p0[r] = __builtin_amdgcn_exp2f(p0[r] - mn); p1[r] = __builtin_amdgcn_exp2f(p1[r] - mn); rs += p0[r] + p1[r]; }
            l_run = l_run * alpha + rs;
#pragma unroll
            for (int r = 0; r < 16; ++r) { o0[r] *= alpha; o1[r] *= alpha; }
            u32x4 pw[4];
#pragma unroll
            for (int s = 0; s < 2; ++s) {
                pw[s] = (u32x4){cvtpk(p0[8 * s], p0[8 * s + 1]), cvtpk(p0[8 * s + 2], p0[8 * s + 3]), cvtpk(p0[8 * s + 4], p0[8 * s + 5]), cvtpk(p0[8 * s + 6], p0[8 * s + 7])};
                pw[2 + s] = (u32x4){cvtpk(p1[8 * s], p1[8 * s + 1]), cvtpk(p1[8 * s + 2], p1[8 * s + 3]), cvtpk(p1[8 * s + 4], p1[8 * s + 5]), cvtpk(p1[8 * s + 6], p1[8 * s + 7])};
            }
#pragma unroll
            for (int ks = 0; ks < 4; ++ks) {
                const bf16x8 va = *(const LAS bf16x8*)(vb + ks * 32), vb2 = *(const LAS bf16x8*)(vb + 32 * 144 + ks * 32);
                const bf16x8 pb = __builtin_bit_cast(bf16x8, pw[ks]);
                o0 = MFMA32(va, pb, o0); o1 = MFMA32(vb2, pb, o1);
            }
        }
        if (t + 1 < NT) AT_STORE((t + 1) & 1);
        __syncthreads();
    }
#undef AT_LOAD
#undef AT_STORE
    const float lt = l_run + __shfl_xor(l_run, 32);
    if (!SAMPLE) {
        const float inv = 1.f / lt;
        bf16_t* od = Ob + (size_t)rloc * 512 + 4 * hi;
#pragma unroll
        for (int rg = 0; rg < 4; ++rg) {
            u32x2 a, b; a.x = cvtpk(o0[4 * rg] * inv, o0[4 * rg + 1] * inv); a.y = cvtpk(o0[4 * rg + 2] * inv, o0[4 * rg + 3] * inv);
            b.x = cvtpk(o1[4 * rg] * inv, o1[4 * rg + 1] * inv); b.y = cvtpk(o1[4 * rg + 2] * inv, o1[4 * rg + 3] * inv);
            *(u32x2*)(od + 8 * rg) = a; *(u32x2*)(od + 32 + 8 * rg) = b;
        }
    } else {
        LAS float* cm = (LAS float*)lds; LAS float* cl = cm + 128; LAS float* co = cm + 256;
        if (r32 < 16) {
            if (hi == 0) { cm[w * 16 + r32] = m_run; cl[w * 16 + r32] = lt; }
#pragma unroll
            for (int r = 0; r < 16; ++r) { const int d = (r & 3) + 8 * (r >> 2) + 4 * hi; co[(w * 16 + r32) * 64 + d] = o0[r]; co[(w * 16 + r32) * 64 + 32 + d] = o1[r]; }
        }
        __syncthreads();
        {
            const int q = tid >> 5, dp = (tid & 31) * 2;
            float M = cm[q];
#pragma unroll
            for (int ww = 1; ww < 8; ++ww) M = fmaxf(M, cm[ww * 16 + q]);
            float L = 0.f, x0 = 0.f, x1 = 0.f;
#pragma unroll
            for (int ww = 0; ww < 8; ++ww) { const float f = __builtin_amdgcn_exp2f(cm[ww * 16 + q] - M); L += f * cl[ww * 16 + q]; x0 += f * co[(ww * 16 + q) * 64 + dp]; x1 += f * co[(ww * 16 + q) * 64 + dp + 1]; }
            const float inv = 1.f / L;
            *(unsigned*)(Ob + (size_t)q * 512 + dp) = cvtpk(x0 * inv, x1 * inv);
        }
        __syncthreads();
    }
}


DEVI void at_compute(const LAS unsigned char* tb, int r32, int hi, const bf16x8 (&qr)[6], bool first, f32x16& negm, float& m_ref, float& l_run, f32x16& o0, f32x16& o1) {
    const LAS unsigned char* kb = tb + r32 * 208 + hi * 16;
    const LAS unsigned char* vb = tb + AT_KB + r32 * 144 + hi * 16;
    f32x16 p0 = negm, p1 = negm;
    bf16x8 kf[12];
#pragma unroll
    for (int d0 = 0; d0 < 6; ++d0) { kf[2 * d0] = *(const LAS bf16x8*)(kb + d0 * 32); kf[2 * d0 + 1] = *(const LAS bf16x8*)(kb + 32 * 208 + d0 * 32); }
    __builtin_amdgcn_sched_barrier(0);
#pragma unroll
    for (int d0 = 0; d0 < 6; ++d0) { p0 = MFMA32(kf[2 * d0], qr[d0], p0); p1 = MFMA32(kf[2 * d0 + 1], qr[d0], p1); }
    bf16x8 vf[8];
#pragma unroll
    for (int ks = 0; ks < 4; ++ks) { vf[2 * ks] = *(const LAS bf16x8*)(vb + ks * 32); vf[2 * ks + 1] = *(const LAS bf16x8*)(vb + 32 * 144 + ks * 32); }
    __builtin_amdgcn_sched_barrier(0);
    asm volatile("s_nop 15\n\ts_nop 7" : "+v"(p0), "+v"(p1));
    float mxa = max3a(p0[0], p0[1], p1[0]), mxb = max3a(p0[2], p0[3], p1[1]);
    mxa = max3a(mxa, p1[2], p1[3]);
#pragma unroll
    for (int r = 4; r < 16; r += 4) { mxa = max3a(mxa, p0[r], p0[r + 1]); mxb = max3a(mxb, p0[r + 2], p0[r + 3]); mxa = max3a(mxa, p1[r], p1[r + 1]); mxb = max3a(mxb, p1[r + 2], p1[r + 3]); }
    float mx = max2a(mxa, mxb);
    mx = max2a(mx, __shfl_xor(mx, 32));
    if (first || __any(mx > 8.f)) {
        const float d = first ? mx : max2a(mx, 0.f);
        m_ref += d;
        const float alpha = first ? 1.f : __builtin_amdgcn_exp2f(-d);
        l_run *= alpha;
#pragma unroll
        for (int r = 0; r < 16; ++r) { p0[r] -= d; p1[r] -= d; negm[r] -= d; o0[r] *= alpha; o1[r] *= alpha; }
    }
    float rs = 0.f;
#pragma unroll
    for (int r = 0; r < 16; ++r) { p0[r] = __builtin_amdgcn_exp2f(p0[r]); p1[r] = __builtin_amdgcn_exp2f(p1[r]); rs += p0[r] + p1[r]; }
    l_run += rs;
    u32x4 pw[4];
#pragma unroll
    for (int s = 0; s < 2; ++s) {
        pw[s] = (u32x4){cvtpk(p0[8 * s], p0[8 * s + 1]), cvtpk(p0[8 * s + 2], p0[8 * s + 3]), cvtpk(p0[8 * s + 4], p0[8 * s + 5]), cvtpk(p0[8 * s + 6], p0[8 * s + 7])};
        pw[2 + s] = (u32x4){cvtpk(p1[8 * s], p1[8 * s + 1]), cvtpk(p1[8 * s + 2], p1[8 * s + 3]), cvtpk(p1[8 * s + 4], p1[8 * s + 5]), cvtpk(p1[8 * s + 6], p1[8 * s + 7])};
    }
#pragma unroll
    for (int ks = 0; ks < 4; ++ks) {
        const bf16x8 pb = __builtin_bit_cast(bf16x8, pw[ks]);
        o0 = MFMA32(vf[2 * ks], pb, o0); o1 = MFMA32(vf[2 * ks + 1], pb, o1);
    }
}
DEVI void attn_unit_p(int wv, LAS unsigned char* lds, const bf16_t* Qb, const float* ssq_q, const bf16_t* Kb, const bf16_t* VTb, int ldv, int NT, int vis0, bf16_t* Ob) {
    const int tid = TID(), lane = tid & 63, r32 = lane & 31, hi = lane >> 5, w = __builtin_amdgcn_readfirstlane(tid >> 6);
    const int rloc = 32 * w + r32;
    const int lastvis = vis0 + (w >> 1);
    bf16x8 qr[6];
    {
        const float sq = rsqrtf(ssq_q[(size_t)rloc * 8] * (1.f / 96.f) + EPSF) * QSCALE;
#pragma unroll
        for (int d0 = 0; d0 < 6; ++d0) {
            const u32x4 wq = *(const u32x4*)(Qb + (size_t)rloc * 96 + 16 * d0 + 8 * hi);
            const u32x4 pk = pack8(unpk_lo(wq) * sq, unpk_hi(wq) * sq);
            qr[d0] = __builtin_bit_cast(bf16x8, pk);
        }
    }
    const int kp0 = tid, kp1 = 512 + tid;
    const int koff0 = (kp0 / 12) * 208 + (kp0 % 12) * 16, koff1 = (kp1 / 12) * 208 + (kp1 % 12) * 16;
    const int vd = tid >> 3, vc = tid & 7, voffl = AT_KB + vd * 144 + vc * 16;
    const bf16_t* vsrc = VTb + (size_t)vd * ldv + vc * 8;
    const bool two = tid < 256;
    u32x4 ka0, ka1 = {0u, 0u, 0u, 0u}, va, kb0, kb1 = {0u, 0u, 0u, 0u}, vbb;
#define AT_LD(K0, K1, V, t) do { K0 = *(const u32x4*)(Kb + (size_t)(t) * 6144 + kp0 * 8); if (two) K1 = *(const u32x4*)(Kb + (size_t)(t) * 6144 + kp1 * 8); V = *(const u32x4*)(vsrc + (size_t)(t) * 64); } while (0)
#define AT_ST(K0, K1, V, buf) do { LAS unsigned char* b_ = lds + (buf) * AT_TB; *(LAS u32x4*)(b_ + koff0) = K0; if (two) *(LAS u32x4*)(b_ + koff1) = K1; *(LAS u32x4*)(b_ + voffl) = V; } while (0)
    float m_run = 0.f, l_run = 0.f;
    f32x16 o0, o1, negm;
#pragma unroll
    for (int r = 0; r < 16; ++r) { o0[r] = 0.f; o1[r] = 0.f; negm[r] = 0.f; }
    AT_LD(kb0, kb1, vbb, 0); AT_LD(ka0, ka1, va, 1);
    AT_ST(kb0, kb1, vbb, 0);
    __syncthreads();
    for (int t = 0; t < NT; t += 2) {
        if (t + 2 < NT) AT_LD(kb0, kb1, vbb, t + 2);
        if (t <= lastvis) at_compute(lds, r32, hi, qr, t == 0, negm, m_run, l_run, o0, o1);
        AT_ST(ka0, ka1, va, 1);
        __syncthreads();
        if (t + 3 < NT) AT_LD(ka0, ka1, va, t + 3);
        if (t + 1 <= lastvis) at_compute(lds + AT_TB, r32, hi, qr, false, negm, m_run, l_run, o0, o1);
        if (t + 2 < NT) AT_ST(kb0, kb1, vbb, 0);
        __syncthreads();
    }
#undef AT_LD
#undef AT_ST
    const float lt = l_run + __shfl_xor(l_run, 32);
    const float inv = 1.f / lt;
    bf16_t* od = Ob + (size_t)rloc * 512 + 4 * hi;
#pragma unroll
    for (int rg = 0; rg < 4; ++rg) {
        u32x2 a, b; a.x = cvtpk(o0[4 * rg] * inv, o0[4 * rg + 1] * inv); a.y = cvtpk(o0[4 * rg + 2] * inv, o0[4 * rg + 3] * inv);
        b.x = cvtpk(o1[4 * rg] * inv, o1[4 * rg + 1] * inv); b.y = cvtpk(o1[4 * rg + 2] * inv, o1[4 * rg + 3] * inv);
        *(u32x2*)(od + 8 * rg) = a; *(u32x2*)(od + 32 + 8 * rg) = b;
    }
}

constexpr int FS_PITCH = 528, FS_W = 64 * FS_PITCH, FS_COMB = 2 * FS_W, FS_NBLK = 129;
DEVI bf16x8 pk_regs(const f32x16& x, int s, float sc) {
    u32x4 w; w.x = cvtpk(x[8 * s] * sc, x[8 * s + 1] * sc); w.y = cvtpk(x[8 * s + 2] * sc, x[8 * s + 3] * sc); w.z = cvtpk(x[8 * s + 4] * sc, x[8 * s + 5] * sc); w.w = cvtpk(x[8 * s + 6] * sc, x[8 * s + 7] * sc);
    return __builtin_bit_cast(bf16x8, w);
}
DEVI void sample_attn_fused(int wv, LAS unsigned char* lds, int l, int bh) {
    const int tid = TID(), lane = tid & 63, r32 = lane & 31, hi = lane >> 5, w = __builtin_amdgcn_readfirstlane(tid >> 6);
    const int b = bh >> 3, h = bh & 7;
    unsigned char* ws = WSP();
    {
        const bf16_t* wk = (const bf16_t*)(ws + O_W + (size_t)l * W_LAYER + W_KC); const bf16_t* wvv = (const bf16_t*)(ws + O_W + (size_t)l * W_LAYER + W_VC);
        for (int i = tid; i < 4096; i += 512) {
            const int mat = i >> 11, rem = i & 2047, d = rem >> 5, ch = rem & 31;
            const int srow = mat == 0 ? 256 * (h >> 2) + 128 * (d >> 5) + 32 * (h & 3) + (d & 31) : h * 64 + d;
            const u32x4 v = *(const u32x4*)((mat == 0 ? wk : wvv) + (size_t)srow * 256 + ch * 8);
            *(LAS u32x4*)(lds + mat * FS_W + d * FS_PITCH + ch * 16) = v;
        }
    }
    LAS bf16x8* qf = (LAS bf16x8*)(lds + FS_COMB + 34816) + lane;
    {
        bf16x8 qn[4], qrp[2];
        const int qrow = r32 & 15; const size_t tokrow = (size_t)MP + b * 16 + qrow;
        const bf16_t* Qb = (const bf16_t*)(ws + O_QS) + ((size_t)bh * 16 + qrow) * 96;
        const float* gk = IN(12) + l * 96;
        const float sq = rsqrtf(((const float*)(ws + O_SSQZ) + (size_t)(7 + 8 * l) * MT)[tokrow * 8 + h] * (1.f / 96.f) + EPSF) * QSCALE;
#pragma unroll
        for (int f = 0; f < 4; ++f) {
            const int d0 = 32 * (f >> 1) + 16 * (f & 1) + 4 * hi;
            const u32x2 a = *(const u32x2*)(Qb + d0), c = *(const u32x2*)(Qb + d0 + 8);
            const f32x4 ga = *(const f32x4*)(gk + d0) * sq, gc = *(const f32x4*)(gk + d0 + 8) * sq;
            u32x4 pk; pk.x = cvtpk(bflo(a.x) * ga[0], bfhi(a.x) * ga[1]); pk.y = cvtpk(bflo(a.y) * ga[2], bfhi(a.y) * ga[3]);
            pk.z = cvtpk(bflo(c.x) * gc[0], bfhi(c.x) * gc[1]); pk.w = cvtpk(bflo(c.y) * gc[2], bfhi(c.y) * gc[3]);
            qn[f] = __builtin_bit_cast(bf16x8, pk);
        }
#pragma unroll
        for (int s = 0; s < 2; ++s) {
            const int d0 = 64 + 16 * s + 8 * hi;
            const u32x4 a = *(const u32x4*)(Qb + d0);
            const f32x4 g0 = *(const f32x4*)(gk + d0) * sq, g1 = *(const f32x4*)(gk + d0 + 4) * sq;
            const u32x4 pk = pack8(unpk_lo(a) * g0, unpk_hi(a) * g1);
            qrp[s] = __builtin_bit_cast(bf16x8, pk);
        }
        if (w == 0) { qf[0] = qn[0]; qf[64] = qn[1]; qf[128] = qn[2]; qf[192] = qn[3]; qf[256] = qrp[0]; qf[320] = qrp[1]; }
    }
    __syncthreads();
    const bf16_t* cache_c = (const bf16_t*)(ws + O_CKVB) + ((size_t)l * MC + (size_t)b * 4096) * 256;
    const float* cache_r = IN(3) + ((size_t)l * MC + (size_t)b * 4096) * 32;
    const bf16_t* new_c = (const bf16_t*)(ws + O_CKVN) + (size_t)(b * 16 + (r32 & 15)) * 256;
    const float* new_r = OUTP() + OUT_KRS + ((size_t)l * MS + b * 16 + (r32 & 15)) * 32;
#define FS_CP(kb) ((kb) < 128 ? cache_c + (size_t)((kb) * 32 + r32) * 256 + 32 * hi : new_c + 32 * hi)
#define FS_KO(ks) (64 * ((ks) >> 2) + 8 * ((ks) & 3))
#define FS_RP(kb) ((kb) < 128 ? cache_r + (size_t)((kb) * 32 + r32) * 32 + 8 * hi : new_r + 8 * hi)
    bf16x8 cf[16]; f32x4 kr0, kr1, kr2, kr3;
    {
        const bf16_t* cp = FS_CP(w); const float* rp = FS_RP(w);
#pragma unroll
        for (int ks = 0; ks < 16; ++ks) cf[ks] = *(const bf16x8*)(cp + FS_KO(ks));
        kr0 = *(const f32x4*)rp; kr1 = *(const f32x4*)(rp + 4); kr2 = *(const f32x4*)(rp + 16); kr3 = *(const f32x4*)(rp + 20);
    }
    float m_run = -INFINITY, l_run = 0.f;
    f32x16 o0, o1;
#pragma unroll
    for (int r = 0; r < 16; ++r) { o0[r] = 0.f; o1[r] = 0.f; }
    const LAS unsigned char* wkl = lds + r32 * FS_PITCH + hi * 64;
    const LAS unsigned char* wvl = lds + FS_W + r32 * FS_PITCH + hi * 64;
#pragma unroll 1
    for (int kb = w; kb < FS_NBLK; kb += 8) {
        const int nkb = kb + 8; const bool more = nkb < FS_NBLK;
        const bf16_t* ncp = FS_CP(more ? nkb : kb); const float* nrp = FS_RP(more ? nkb : kb);
        f32x16 x0, x1;
#pragma unroll
        for (int r = 0; r < 16; ++r) { x0[r] = 0.f; x1[r] = 0.f; }
#pragma unroll
        for (int ks = 0; ks < 16; ++ks) {
            const bf16x8 a0 = *(const LAS bf16x8*)(wkl + 2 * FS_KO(ks)), a1 = *(const LAS bf16x8*)(wkl + 32 * FS_PITCH + 2 * FS_KO(ks));
            x0 = MFMA32(a0, cf[ks], x0); x1 = MFMA32(a1, cf[ks], x1);
            if ((ks & 3) == 3) __builtin_amdgcn_sched_barrier(0);
        }
        float ss = (ss4(kr0) + ss4(kr1)) + (ss4(kr2) + ss4(kr3));
#pragma unroll
        for (int r = 0; r < 16; ++r) ss += x0[r] * x0[r] + x1[r] * x1[r];
        ss += __shfl_xor(ss, 32);
        const float sk = rsqrtf(ss * (1.f / 96.f) + EPSF);
        f32x16 p;
#pragma unroll
        for (int r = 0; r < 16; ++r) p[r] = 0.f;
        p = MFMA32(pk_regs(x0, 0, sk), qf[0], p); p = MFMA32(pk_regs(x0, 1, sk), qf[64], p);
        p = MFMA32(pk_regs(x1, 0, sk), qf[128], p); p = MFMA32(pk_regs(x1, 1, sk), qf[192], p);
        { const u32x4 k0 = pack8(kr0 * sk, kr1 * sk), k1 = pack8(kr2 * sk, kr3 * sk);
          p = MFMA32(__builtin_bit_cast(bf16x8, k0), qf[256], p); p = MFMA32(__builtin_bit_cast(bf16x8, k1), qf[320], p); }
        if (more) { kr0 = *(const f32x4*)nrp; kr1 = *(const f32x4*)(nrp + 4); kr2 = *(const f32x4*)(nrp + 16); kr3 = *(const f32x4*)(nrp + 20); }
        if (kb == 128) {
#pragma unroll
            for (int r = 8; r < 16; ++r) p[r] = -INFINITY;
        }
        float mx = p[0];
#pragma unroll
        for (int r = 1; r < 16; ++r) mx = fmaxf(mx, p[r]);
        mx = fmaxf(mx, __shfl_xor(mx, 32));
        const float mn = fmaxf(m_run, mx), alpha = __builtin_amdgcn_exp2f(m_run - mn);
        m_run = mn;
        float rs = 0.f;
#pragma unroll
        for (int r = 0; r < 16; ++r) { p[r] = __builtin_amdgcn_exp2f(p[r] - mn); rs += p[r]; }
        l_run = l_run * alpha + rs;
#pragma unroll
        for (int r = 0; r < 16; ++r) { o0[r] *= alpha; o1[r] *= alpha; }
        const bf16x8 pb0 = pk_regs(p, 0, 1.f), pb1 = pk_regs(p, 1, 1.f);
        {
            f32x16 v;
#pragma unroll
            for (int r = 0; r < 16; ++r) v[r] = 0.f;
#pragma unroll
            for (int ks = 0; ks < 16; ++ks) { v = MFMA32(cf[ks], *(const LAS bf16x8*)(wvl + 2 * FS_KO(ks)), v); if ((ks & 3) == 3) __builtin_amdgcn_sched_barrier(0); }
            o0 = MFMA32(pk_regs(v, 0, 1.f), pb0, o0); o0 = MFMA32(pk_regs(v, 1, 1.f), pb1, o0);
        }
        {
            f32x16 v;
#pragma unroll
            for (int r = 0; r < 16; ++r) v[r] = 0.f;
#pragma unroll
            for (int ks = 0; ks < 16; ++ks) {
                v = MFMA32(cf[ks], *(const LAS bf16x8*)(wvl + 32 * FS_PITCH + 2 * FS_KO(ks)), v);
                if (more) cf[ks] = *(const bf16x8*)(ncp + FS_KO(ks));
                if ((ks & 3) == 3) __builtin_amdgcn_sched_barrier(0);
            }
            o1 = MFMA32(pk_regs(v, 0, 1.f), pb0, o1); o1 = MFMA32(pk_regs(v, 1, 1.f), pb1, o1);
        }
    }
#undef FS_CP
#undef FS_KO
#undef FS_RP
    const float lt = l_run + __shfl_xor(l_run, 32);
    LAS float* cm = (LAS float*)(lds + FS_COMB); LAS float* cl = cm + 128; LAS float* co = cm + 256;
    if (r32 < 16) {
        if (hi == 0) { cm[w * 16 + r32] = m_run; cl[w * 16 + r32] = lt; }
#pragma unroll
        for (int r = 0; r < 16; ++r) { const int d = (r & 3) + 8 * (r >> 2) + 4 * hi; co[(w * 16 + r32) * 64 + d] = o0[r]; co[(w * 16 + r32) * 64 + 32 + d] = o1[r]; }
    }
    __syncthreads();
    {
        const int q = tid >> 5, dp = (tid & 31) * 2;
        float M = cm[q];
#pragma unroll
        for (int ww = 1; ww < 8; ++ww) M = fmaxf(M, cm[ww * 16 + q]);
        float L = 0.f, y0 = 0.f, y1 = 0.f;
#pragma unroll
        for (int ww = 0; ww < 8; ++ww) { const float f = __builtin_amdgcn_exp2f(cm[ww * 16 + q] - M); L += f * cl[ww * 16 + q]; y0 += f * co[(ww * 16 + q) * 64 + dp]; y1 += f * co[(ww * 16 + q) * 64 + dp + 1]; }
        const float inv = 1.f / L;
        *(unsigned*)((bf16_t*)(ws + O_ATT) + ((size_t)MP + b * 16 + q) * 512 + h * 64 + dp) = cvtpk(y0 * inv, y1 * inv);
    }
    __syncthreads();
}
static_assert(FS_COMB + 34816 + 6 * 64 * 16 <= LDS_BYTES && (256 + 8 * 16 * 64) * 4 <= 34816, "fused sample attention LDS");

struct Args { const float* in[21]; float* out; unsigned char* ws; };

__device__ const double ROPE_INV[16] = {1.0, 0.5623413251903491, 0.31622776601683794, 0.1778279410038923, 0.1, 0.05623413251903491, 0.03162277660168379, 0.01778279410038923, 0.01, 0.005623413251903491,
                                        0.0031622776601683794, 0.0017782794100389228, 0.001, 0.0005623413251903491, 0.00031622776601683794, 0.00017782794100389227};

DEVI void tr_item(const float* W, int N, int K, const float* gain, bf16_t* WT, int dest0, LAS float* scr, int k0, int n0, int lane) {
#pragma unroll
    for (int i = 0; i < 32; ++i) { const int kk = 2 * i + (lane >> 5); float v = W[(size_t)(k0 + kk) * N + n0 + (lane & 31)]; if (gain) v *= gain[k0 + kk]; scr[kk * 33 + (lane & 31)] = v; }
    asm volatile("s_waitcnt lgkmcnt(0)" ::: "memory");
    const int c = lane & 7;
#pragma unroll
    for (int j = 0; j < 4; ++j) { const int n = (lane >> 3) + 8 * j; const LAS float* s = scr + (8 * c) * 33 + n;
        u32x4 o; o.x = cvtpk(s[0], s[33]); o.y = cvtpk(s[2 * 33], s[3 * 33]); o.z = cvtpk(s[4 * 33], s[5 * 33]); o.w = cvtpk(s[6 * 33], s[7 * 33]);
        *(u32x4*)(WT + (size_t)(dest0 + n) * K + k0 + 8 * c) = o; }
    asm volatile("s_waitcnt lgkmcnt(0)" ::: "memory");
}


template <class Epi>
DEVI void run_gemm(int wv, LAS unsigned char* lds, const bf16_t* A, const bf16_t* Bt, int lda, int ldb, int M, int N, int K, int& off, const Epi& E, int nNr = 0) {
    const int G = GDIM();
    pg8::Gemm g{A, Bt, lda, ldb, K, nNr};
    pg8::StaticOrder S; S.init(M, N, G, (int)((BID() + G - (off % G)) % G));
    pg8::gemm_phase<Epi, pg8::StaticOrder>(wv, lds, g, S, E);
    off += (M / 256) * (N / 256);
}

DEVI void prologue(int wv, LAS unsigned char* lds) {
    const int tid = TID(), lane = tid & 63, wave = __builtin_amdgcn_readfirstlane(tid >> 6);
    const int G = GDIM(), bx = BID();
    const int gw = bx * 8 + wave, NGW = G * 8;
    const size_t gt = (size_t)bx * 512 + tid, NGT = (size_t)G * 512;
    unsigned char* ws = WSP();
    LAS float* scr = (LAS float*)(lds + wave * 8448);
    constexpr int I_IN = 16 * 101, I_UQ = 6 * 24, I_KV = 4 * 32, I_A = 8 * 32, I_O = 16 * 32, I_UP = 16 * 128, I_DN = 64 * 32;
    constexpr int I_L = I_IN + I_UQ + 2 * I_KV + I_A + I_O + I_UP + I_DN;
    for (int it = gw; it < 2 * I_L; it += NGW) {
        const int l = it / I_L; int r = it % I_L;
        unsigned char* wl = ws + O_W + (size_t)l * W_LAYER;
        if (r < I_IN) { const int kb = r / 101, nb = r % 101, n0 = nb * 32;
            const int d0 = n0 < 384 ? n0 : n0 < 640 ? 512 + (n0 - 384) : n0 < 672 ? 384 + (n0 - 640) : n0 < 1184 ? 768 + (n0 - 672) : n0 < 2208 ? 1280 + (n0 - 1184) : 2304 + (n0 - 2208);
            tr_item(IN(6) + (size_t)l * 1024 * 3232, 3232, 1024, IN(5) + l * 1024, (bf16_t*)(wl + W_IN), d0, scr, kb * 64, n0, lane); continue; }
        r -= I_IN;
        if (r < I_UQ) { const int kb = r / 24, nb = r % 24, n0 = nb * 32, hd = n0 / 96, dim0 = n0 % 96;
            const int d0 = dim0 < 64 ? 256 * (hd >> 2) + 128 * (dim0 >> 5) + 32 * (hd & 3) : 512 + 128 * (hd >> 2) + 32 * (hd & 3);
            tr_item(IN(9) + (size_t)l * 384 * 768, 768, 384, IN(7) + l * 384, (bf16_t*)(wl + W_UQ), d0, scr, kb * 64, n0, lane); continue; }
        r -= I_UQ;
        if (r < 2 * I_KV) { const int fold = r < I_KV; if (!fold) r -= I_KV;
            const int kb = r / 32, nb = r % 32, n0 = nb * 32, hd = n0 / 128, dim0 = n0 % 128;
            const bool isk = dim0 < 64;
            const int d0 = isk ? 256 * (hd >> 2) + 128 * (dim0 >> 5) + 32 * (hd & 3) : hd * 64 + (dim0 - 64);
            bf16_t* dst = (bf16_t*)(wl + (fold ? (isk ? W_K : W_V) : (isk ? W_KC : W_VC)));
            tr_item(IN(10) + (size_t)l * 256 * 1024, 1024, 256, fold ? IN(8) + l * 256 : nullptr, dst, d0, scr, kb * 64, n0, lane); continue; }
        r -= 2 * I_KV;
        if (r < I_A) { tr_item(IN(13) + (size_t)l * 512 * 1024, 1024, 512, nullptr, (bf16_t*)(wl + W_A), (r % 32) * 32, scr, (r / 32) * 64, (r % 32) * 32, lane); continue; }
        r -= I_A;
        if (r < I_O) { tr_item(IN(17) + (size_t)l * 1024 * 1024, 1024, 1024, nullptr, (bf16_t*)(wl + W_O), (r % 32) * 32, scr, (r / 32) * 64, (r % 32) * 32, lane); continue; }
        r -= I_O;
        if (r < I_UP) { tr_item(IN(19) + (size_t)l * 1024 * 4096, 4096, 1024, IN(18) + l * 1024, (bf16_t*)(wl + W_UP), (r % 128) * 32, scr, (r / 128) * 64, (r % 128) * 32, lane); continue; }
        r -= I_UP;
        tr_item(IN(20) + (size_t)l * 4096 * 1024, 1024, 4096, nullptr, (bf16_t*)(wl + W_DN), (r % 32) * 32, scr, (r / 32) * 64, (r % 32) * 32, lane);
    }
    for (size_t i = gt; i < (size_t)2 * 96 * 1024 / 8; i += NGT) { const size_t l = i / (96 * 128), rem = i % (96 * 128);
        *(u32x4*)(ws + O_W + l * W_LAYER + W_IN + ((size_t)416 * 1024) * 2 + rem * 16) = (u32x4){0u, 0u, 0u, 0u}; }
    {
        const float* wpool = IN(14); const float* pscale = IN(15); const float* wpo = IN(16);
        for (size_t it = gt; it < (size_t)2 * 65536; it += NGT) {
            const int l = (int)(it >> 16), r = (int)(it & 65535), kc = r >> 10, n = r & 1023, g = kc >> 4, c0 = (kc & 15) * 8;
            const float* wp = wpool + (size_t)l * 4 * 128 * 128 + ((size_t)g * 128 + c0) * 128;
            const float* ps = pscale + l * 512 + g * 128;
            const float* wo = wpo + (size_t)l * 512 * 1024 + (size_t)g * 128 * 1024 + n;
            float a0 = 0.f, a1 = 0.f, a2 = 0.f, a3 = 0.f, a4 = 0.f, a5 = 0.f, a6 = 0.f, a7 = 0.f;
#pragma unroll 16
            for (int e = 0; e < 128; ++e) { const float x = wo[(size_t)e * 1024] * ps[e];
                a0 += wp[e] * x; a1 += wp[128 + e] * x; a2 += wp[256 + e] * x; a3 += wp[384 + e] * x; a4 += wp[512 + e] * x; a5 += wp[640 + e] * x; a6 += wp[768 + e] * x; a7 += wp[896 + e] * x; }
            u32x4 o; o.x = cvtpk(a0, a1); o.y = cvtpk(a2, a3); o.z = cvtpk(a4, a5); o.w = cvtpk(a6, a7);
            *(u32x4*)((bf16_t*)(ws + O_W + (size_t)l * W_LAYER + W_EFF) + (size_t)n * 512 + g * 128 + c0) = o;
        }
    }
    {
        const float* x_p = IN(0); const float* x_s = IN(1); bf16_t* xb = (bf16_t*)(ws + O_XB); float* ssqA0 = (float*)(ws + O_SSQA0);
        for (int row0 = gw; row0 < MT; row0 += 4 * NGW) {
            f32x4 v[4][4];
#pragma unroll
            for (int k = 0; k < 4; ++k) { const int row = row0 + k * NGW;
                if (row < MT) { const float* xr = row < MP ? x_p + (size_t)row * 1024 : x_s + (size_t)(row - MP) * 1024;
#pragma unroll
                    for (int j = 0; j < 4; ++j) v[k][j] = *(const f32x4*)(xr + 256 * j + 4 * lane); } }
#pragma unroll
            for (int k = 0; k < 4; ++k) { const int row = row0 + k * NGW;
                if (row < MT) { float s = 0.f;
#pragma unroll
                    for (int j = 0; j < 4; ++j) { s += ss4(v[k][j]); u32x2 o; o.x = cvtpk(v[k][j][0], v[k][j][1]); o.y = cvtpk(v[k][j][2], v[k][j][3]); *(u32x2*)(xb + (size_t)row * 1024 + 256 * j + 4 * lane) = o; }
#pragma unroll
                    for (int o = 1; o < 64; o <<= 1) s += __shfl_xor(s, o);
                    if (lane == 0) ssqA0[row] = s; } }
        }
    }
    {
        const float* cache_ckv = IN(2); bf16_t* ckvb = (bf16_t*)(ws + O_CKVB);
        for (size_t i = gt; i < (size_t)2 * MC * 256 / 8; i += 8 * NGT) {
            f32x4 a[8], b[8];
#pragma unroll
            for (int k = 0; k < 8; ++k) { const size_t ii = i + k * NGT; if (ii < (size_t)2 * MC * 256 / 8) { a[k] = *(const f32x4*)(cache_ckv + ii * 8); b[k] = *(const f32x4*)(cache_ckv + ii * 8 + 4); } }
#pragma unroll
            for (int k = 0; k < 8; ++k) { const size_t ii = i + k * NGT; if (ii < (size_t)2 * MC * 256 / 8) *(u32x4*)(ckvb + ii * 8) = pack8(a[k], b[k]); }
        }
    }
    { float* ssqz = (float*)(ws + O_SSQZ); for (size_t i = gt; i < SSQZ_FLOATS; i += NGT) ssqz[i] = 0.f; }
}

DEVI void thin_rows(int wv, int l) {
    const int tid = TID(), lane = tid & 63, wave = __builtin_amdgcn_readfirstlane(tid >> 6);
    const int gw = BID() * 8 + wave, NGW = GDIM() * 8;
    unsigned char* ws = WSP(); float* out = OUTP();
    const float* gkva = IN(8) + l * 256;
    const float* sp = IN(4) + (size_t)l * 32 * 15 * 512;
    const float* ssq_zkv = (const float*)(ws + O_SSQZ) + (size_t)(5 + l) * MT;
    const bf16_t* zkv = (const bf16_t*)(ws + O_ZKV); const bf16_t* pp = (const bf16_t*)(ws + O_PP); bf16_t* pooled = (bf16_t*)(ws + O_POOLED);
    float* ockv_p = out + OUT_CKVP + (size_t)l * MP * 256; float* ockv_s = out + OUT_CKVS + (size_t)l * MS * 256;
    for (int c = gw; c < MT / 16; c += NGW) {
        const int r0 = c * 16; const bool samp = r0 >= MP;
        {
            u32x2 z[16]; float sq[16];
#pragma unroll
            for (int i = 0; i < 16; ++i) { z[i] = *(const u32x2*)(zkv + (size_t)(r0 + i) * 256 + 4 * lane); sq[i] = ssq_zkv[r0 + i]; }
            const f32x4 g = *(const f32x4*)(gkva + 4 * lane);
            float* d0 = samp ? ockv_s + (size_t)(r0 - MP) * 256 : ockv_p + (size_t)r0 * 256;
#pragma unroll
            for (int i = 0; i < 16; ++i) {
                const float r = rsqrtf(sq[i] * (1.f / 256.f) + EPSF);
                f32x4 v = {bflo(z[i].x), bfhi(z[i].x), bflo(z[i].y), bfhi(z[i].y)}; v = v * r * g;
                __builtin_nontemporal_store(v, (f32x4*)(d0 + (size_t)i * 256 + 4 * lane));
                if (samp) { u32x2 o; o.x = cvtpk(v[0], v[1]); o.y = cvtpk(v[2], v[3]); *(u32x2*)((bf16_t*)(ws + O_CKVN) + (size_t)(r0 - MP + i) * 256 + 4 * lane) = o; }
            }
        }
        {
            const int grp = lane >> 4, wsz = 2 << grp, ch = 8 * lane;
            u32x4 rw[31];
            const int t0 = r0 & 4095;
            if (!samp) {
#pragma unroll
                for (int k = 0; k < 15; ++k) rw[k] = (t0 >= 16) ? *(const u32x4*)(pp + (size_t)(r0 - 15 + k) * 512 + ch) : (u32x4){0u, 0u, 0u, 0u};
            } else {
                const float* q = sp + (size_t)((r0 - MP) >> 4) * 15 * 512 + ch;
#pragma unroll
                for (int k = 0; k < 15; ++k) rw[k] = pack8(*(const f32x4*)(q + (size_t)k * 512), *(const f32x4*)(q + (size_t)k * 512 + 4));
            }
#pragma unroll
            for (int k = 15; k < 31; ++k) rw[k] = *(const u32x4*)(pp + (size_t)(r0 + k - 15) * 512 + ch);
            f32x4 s0 = {0.f, 0.f, 0.f, 0.f}, s1 = s0;
#pragma unroll
            for (int j = 0; j < 16; ++j) if (j < wsz) { s0 += unpk_lo(rw[15 - j]); s1 += unpk_hi(rw[15 - j]); }
#pragma unroll
            for (int i = 0; i < 16; ++i) {
                if (i > 0) {
                    const u32x4 od = grp == 0 ? rw[13 + i] : grp == 1 ? rw[11 + i] : grp == 2 ? rw[7 + i] : rw[i - 1];
                    s0 += unpk_lo(rw[15 + i]) - unpk_lo(od); s1 += unpk_hi(rw[15 + i]) - unpk_hi(od);
                }
                const float ic = 1.f / (float)(samp ? wsz : min(wsz, t0 + i + 1));
                *(u32x4*)(pooled + (size_t)(r0 + i) * 512 + ch) = pack8(s0 * ic - unpk_lo(rw[15 + i]), s1 * ic - unpk_hi(rw[15 + i]));
            }
        }
    }
}

DEVI void attn_phase(int wv, LAS unsigned char* lds, int l) {
    const int G = GDIM(), bx = BID();
    const int vcu = (G % 8 == 0) ? (bx % 8) * (G / 8) + bx / 8 : bx;
    for (int pi = vcu; pi < 512; pi += G) {
        const int bh = pi >> 3, s = pi & 7, b = bh >> 3, h = bh & 7;
#pragma unroll 1
        for (int k = 0; k < 2; ++k) {
            unsigned char* ws = WSP();
            const float* ssq_qh = (const float*)(ws + O_SSQZ) + (size_t)(7 + 8 * l) * MT;
            const int qb = k == 0 ? s : 15 - s, q0 = qb * 256; const size_t tok0 = (size_t)b * 4096 + q0;
            attn_unit_p(wv, lds, (const bf16_t*)(ws + O_QP) + ((size_t)bh * 4096 + q0) * 96, ssq_qh + tok0 * 8 + h, (const bf16_t*)(ws + O_KP) + (size_t)bh * 4096 * 96,
                             (const bf16_t*)(ws + O_VTP) + (size_t)bh * 64 * 4096, 4096, 4 * qb + 4, 4 * qb, (bf16_t*)(ws + O_ATT) + tok0 * 512 + h * 64);
        }
    }
    for (int bh = vcu; bh < 256; bh += G) sample_attn_fused(wv, lds, l, bh);
}

static_assert((size_t)16 * MS * 1024 * 4 <= (size_t)MT * (384 + 256) * 2, "split-K partial buffer fits the dead q/kv-latent region");
DEVI void sample_fixup(int wv, int wxb) {
    const int tid = TID(), lane = tid & 63, wave = __builtin_amdgcn_readfirstlane(tid >> 6);
    const int gw = BID() * 8 + wave, NGW = GDIM() * 8;
    unsigned char* ws = WSP(); float* x = OUTP();
    const float* part = (const float*)(ws + O_ZQ);
    bf16_t* xb = (bf16_t*)(ws + O_XB); float* ssqA1 = (float*)(ws + O_SSQZ);
    for (int row = MP + gw; row < MT; row += NGW) {
        float s = 0.f;
#pragma unroll
        for (int j = 0; j < 4; ++j) {
            f32x4 v = *(const f32x4*)(x + (size_t)row * 1024 + 256 * j + 4 * lane);
#pragma unroll
            for (int k = 0; k < 16; ++k) v += *(const f32x4*)(part + ((size_t)k * MS + (row - MP)) * 1024 + 256 * j + 4 * lane);
            *(f32x4*)(x + (size_t)row * 1024 + 256 * j + 4 * lane) = v;
            s += ss4(v);
            if (wxb) { u32x2 o; o.x = cvtpk(v[0], v[1]); o.y = cvtpk(v[2], v[3]); *(u32x2*)(xb + (size_t)row * 1024 + 256 * j + 4 * lane) = o; }
        }
#pragma unroll
        for (int o = 1; o < 64; o <<= 1) s += __shfl_xor(s, o);
        if (wxb && lane == 0) ssqA1[row] = s;
    }
}

#define XB_TMO      128
#define XB_XCNT(j)  (256  + 64 * (j))
#define XB_XSUB(j)  (1280 + 64 * (j))
#define XB_XGEN(j)  (2304 + 64 * (j))
#define XB_TOP      3328
#define XB_TOPGEN   3392
#define XB_SPIN_CAP (1u << 18)
constexpr int LDS_MISC = 131072 + 320;
DEVI unsigned xb_ld(unsigned* p)              { return __hip_atomic_load(p, __ATOMIC_RELAXED, __HIP_MEMORY_SCOPE_AGENT); }
DEVI unsigned xb_add(unsigned* p, unsigned v) { return __hip_atomic_fetch_add(p, v, __ATOMIC_RELAXED, __HIP_MEMORY_SCOPE_AGENT); }
DEVI unsigned xb_xcc_id() { return (unsigned)__builtin_amdgcn_s_getreg((3 << 11) | 20) & 0xFu; }
#define XB_SPIN(cond, bar) do { unsigned _sp = 0; while (cond) { __builtin_amdgcn_s_sleep(1); \
    if ((++_sp & 255u) == 0u) { if (xb_ld(&(bar)[XB_TMO])) break; if (_sp > XB_SPIN_CAP) { atomicAdd(&(bar)[XB_TMO], 1u); break; } } } } while (0)
DEVI void xcd_barrier_post(int wv, LAS unsigned char* lds) {
    if (TID() == 0) {
        unsigned* bar = (unsigned*)(WSP() + O_CTL);
        volatile LAS unsigned* st = (volatile LAS unsigned*)(lds + LDS_MISC);
        st[0] = 0u; st[1] = 0u;
        (void)xb_add(&bar[XB_XCNT(xb_xcc_id())], 1u);
    }
    __syncthreads();
}
DEVI void xcd_barrier_complete(unsigned* bar, unsigned x, unsigned& nloc, unsigned& nx) {
    const unsigned G = (unsigned)gridDim.x;
    unsigned sum, cnt, mine, sp = 0u;
    for (;;) {
        sum = 0u; cnt = 0u; mine = 0u;
#pragma unroll
        for (unsigned j = 0; j < 16; ++j) { const unsigned c = xb_ld(&bar[XB_XCNT(j)]); sum += c; cnt += (c > 0u) ? 1u : 0u; mine = (j == x) ? c : mine; }
        if (sum == G) break;
        __builtin_amdgcn_s_sleep(1);
        if ((++sp & 255u) == 0u) { if (xb_ld(&bar[XB_TMO])) break; if (sp > XB_SPIN_CAP) { atomicAdd(&bar[XB_TMO], 1u); break; } }
    }
    nloc = mine > 0u ? mine : 1u; nx = cnt > 0u ? cnt : 1u;
}
DEVI void grid_bar(int wv, LAS unsigned char* lds) {
    asm volatile("s_waitcnt vmcnt(0)" ::: "memory");
    __syncthreads();
    if (TID() == 0) {
        unsigned* bar = (unsigned*)(WSP() + O_CTL);
        volatile LAS unsigned* st = (volatile LAS unsigned*)(lds + LDS_MISC);
        const unsigned x = xb_xcc_id();
        __builtin_amdgcn_s_waitcnt(0);
        unsigned nloc = st[0], nx = st[1];
        if (nloc == 0u) { xcd_barrier_complete(bar, x, nloc, nx); st[0] = nloc; st[1] = nx; }
        const unsigned old = xb_add(&bar[XB_XSUB(x)], 1u);
        const unsigned gen = old / nloc;
        if (old + 1u == (gen + 1u) * nloc) {
            __builtin_amdgcn_fence(__ATOMIC_RELEASE, "agent");
            asm volatile("s_waitcnt vmcnt(0)" ::: "memory");
            const unsigned og = xb_add(&bar[XB_TOP], 1u);
            const unsigned tg = og / nx;
            if (og + 1u == (tg + 1u) * nx) xb_add(&bar[XB_TOPGEN], 1u);
            else XB_SPIN(xb_ld(&bar[XB_TOPGEN]) == tg, bar);
            __builtin_amdgcn_fence(__ATOMIC_ACQUIRE, "agent");
            xb_add(&bar[XB_XGEN(x)], 1u);
            asm volatile("s_waitcnt vmcnt(0)" ::: "memory");
        } else {
            XB_SPIN(xb_ld(&bar[XB_XGEN(x)]) == gen, bar);
            __builtin_amdgcn_fence(__ATOMIC_ACQUIRE, "agent");
            asm volatile("s_waitcnt vmcnt(0)" ::: "memory");
        }
    }
    __syncthreads();
}

#define WL(l, o) ((const bf16_t*)(WSP() + O_W + (size_t)(l) * W_LAYER + (o)))
#define WSB(o) ((const bf16_t*)(WSP() + (o)))

__global__ void __launch_bounds__(512, 2) fwd_kernel(Args args_unused) {
    extern __shared__ __attribute__((aligned(16))) unsigned char lds_raw[];
    LAS unsigned char* lds = (LAS unsigned char*)lds_raw;
    cg::grid_group grid = cg::this_grid();
    const int wv = __builtin_amdgcn_readfirstlane((int)threadIdx.x >> 6);
    if (BID() == 0) { unsigned* bw = (unsigned*)(WSP() + O_CTL); for (int i = TID(); i < 4096; i += 512) bw[i] = 0u; }
    grid.sync();
    xcd_barrier_post(wv, lds);
    prologue(wv, lds);
    grid_bar(wv, lds);
#pragma unroll 1
    for (int l = 0; l < 2; ++l) {
        int off = 0;
        { EpiZ E{l}; run_gemm(wv, lds, WSB(O_XB), WL(l, W_IN), 1024, 1024, MT, NZ, 1024, off, E); }
        grid_bar(wv, lds);
        { EpiQ E{l}; run_gemm(wv, lds, WSB(O_ZQ), WL(l, W_UQ), 384, 384, MT, 768, 384, off, E); }
        { EpiK E{l, 0}; run_gemm(wv, lds, WSB(O_ZKV), WL(l, W_K), 256, 256, MP, 512, 256, off, E); }
        { EpiVT E{l, 0}; run_gemm(wv, lds, WL(l, W_V), WSB(O_ZKV), 256, 256, 512, MP, 256, off, E); }
        thin_rows(wv, l);
        grid_bar(wv, lds);
        attn_phase(wv, lds, l);
        { EpiGateB E{}; run_gemm(wv, lds, WSB(O_POOLED), WL(l, W_EFF), 512, 512, MT, 1024, 512, off, E); }
        grid_bar(wv, lds);
        { EpiGateA E{}; run_gemm(wv, lds, WSB(O_ATT), WL(l, W_A), 512, 512, MT, 1024, 512, off, E); }
        grid_bar(wv, lds);
        { EpiRes E{l == 0 ? 1 : 0, 1, 1 + l}; run_gemm(wv, lds, WSB(O_GB), WL(l, W_O), 1024, 1024, MT, 1024, 1024, off, E); }
        grid_bar(wv, lds);
        { EpiUp E{l}; run_gemm(wv, lds, WSB(O_XB), WL(l, W_UP), 1024, 1024, MT, DFF, 1024, off, E); }
        grid_bar(wv, lds);
        { EpiRes E{0, l == 0 ? 1 : 0, 0}; run_gemm(wv, lds, WSB(O_AH), WL(l, W_DN), DFF, DFF, MP, 1024, DFF, off, E); }
        { EpiPartS E{}; run_gemm(wv, lds, WSB(O_AH) + (size_t)MP * DFF, WL(l, W_DN), DFF, DFF, MS, 1024 * 16, 256, off, E, 4); }
        grid_bar(wv, lds);
        sample_fixup(wv, l == 0);
        if (l == 0) grid_bar(wv, lds);
    }
}

extern "C" void kernel_launch(void* const* d_in, const int* in_sizes, int n_in, void* d_out, int out_size, void* d_ws, size_t ws_size, hipStream_t stream) {
    static int grid = 0;
    if (grid == 0) {
        if (n_in != 21 || ws_size < O_END2) { fprintf(stderr, "kernel_launch: need 21 inputs and >= %zu bytes of workspace (got %d, %zu)\n", (size_t)O_END2, n_in, ws_size); grid = -1; return; }
        int dev = 0, cus = 0, per_cu = 0;
        (void)hipGetDevice(&dev); (void)hipDeviceGetAttribute(&cus, hipDeviceAttributeMultiprocessorCount, dev);
        (void)hipFuncSetAttribute((const void*)fwd_kernel, hipFuncAttributeMaxDynamicSharedMemorySize, LDS_BYTES);
        (void)hipOccupancyMaxActiveBlocksPerMultiprocessor(&per_cu, (const void*)fwd_kernel, 512, LDS_BYTES);
        if (per_cu < 1) fprintf(stderr, "kernel_launch: occupancy query says %d blocks per CU\n", per_cu);
        (void)hipGetLastError();
        grid = cus;
    }
    if (grid < 0) return;
    Args a{};
    for (int i = 0; i < 21; ++i) a.in[i] = (const float*)d_in[i];
    a.out = (float*)d_out; a.ws = (unsigned char*)d_ws;
    void* params[] = {&a};
    hipError_t e = hipLaunchCooperativeKernel((const void*)fwd_kernel, dim3(grid), dim3(512), params, LDS_BYTES, stream);
    if (e != hipSuccess) fprintf(stderr, "cooperative launch failed: %s (grid %d)\n", hipGetErrorString(e), grid);
}
```
